# Optimizing an MI355X kernel written in HIP

```python
import math
import jax, jax.numpy as jnp
from jax import lax
import numpy as np


D_MODEL = 1024
BATCH = 8
SEQ = 2048
DEPTH = 2
DEC_BATCH = 128
DEC_SEQ = 8
PAST_LEN = 16384
PAGE_SIZE = 128

N_META = 16
D_MIX = D_MODEL
D_LRU = D_MIX // 2
LRU_BLOCKS = 8
LRU_BW = D_LRU // LRU_BLOCKS
CONV_W = 4
LRU_C = 8.0
GLA_HEADS = 4
GLA_DV = (D_MIX - D_LRU) // GLA_HEADS
GLA_DK = GLA_DV // 2
GLA_RANK = 16
GLA_GATE_NORM = 16.0
GLA_CHUNK = 64
D_FF = 128 * ((8 * D_MODEL // 3 + 127) // 128)
EPS = 1e-6
D_IN = 2 * D_LRU + 2 * GLA_HEADS * GLA_DK + 2 * GLA_HEADS * GLA_DV + GLA_RANK

kernel_name = "hymba_rglru_gla_macaron_step"


def rmsnorm(x, g):
    xf = x.astype(jnp.float32)
    y = xf * lax.rsqrt(jnp.mean(xf * xf, axis=-1, keepdims=True) + EPS)
    return (y * g.astype(jnp.float32)).astype(x.dtype)


def swiglu(x, w_gu, w_down):
    gate, up = jnp.split(x @ w_gu, 2, axis=-1)
    return (jax.nn.silu(gate) * up) @ w_down


def causal_conv(x, buf, w, b):
    L = x.shape[1]
    xp = jnp.concatenate([buf.astype(x.dtype), x], axis=1)
    y = b
    for k in range(CONV_W):
        y = y + w[k] * xp[:, k:k + L]
    return y, xp[:, -(CONV_W - 1):]


def rg_lru(x, h0, pos, wa, ba, wx, bx, lam):
    B, L, _ = x.shape
    xb = x.reshape(B, L, LRU_BLOCKS, LRU_BW)
    r = jax.nn.sigmoid(jnp.einsum('blnc,ncd->blnd', xb, wa).reshape(B, L, D_LRU) + ba)
    i = jax.nn.sigmoid(jnp.einsum('blnc,ncd->blnd', xb, wx).reshape(B, L, D_LRU) + bx)
    log_a = -LRU_C * r.astype(jnp.float32) * jax.nn.softplus(-lam.astype(jnp.float32))
    a = jnp.exp(log_a)
    mult = jnp.sqrt(-jnp.expm1(2.0 * log_a))
    reset = (pos == 0)[None, :, None]
    mult = jnp.where(reset, 1.0, mult)
    a = jnp.where(reset, 0.0, a)
    bt = mult * (i * x).astype(jnp.float32)
    bt = bt.at[:, 0].add(a[:, 0] * h0.astype(jnp.float32))

    def combine(c1, c2):
        a1, b1 = c1
        a2, b2 = c2
        return a1 * a2, a2 * b1 + b2

    _, h = lax.associative_scan(combine, (a, bt), axis=1)
    return h.astype(x.dtype), h[:, -1].astype(x.dtype)


def gla_chunked(q, k, v, g, S0):
    B, L, H, _ = q.shape
    C = math.gcd(L, GLA_CHUNK)
    N = L // C

    def to_chunks(t):
        return t.astype(jnp.float32).reshape(B, N, C, H, t.shape[-1]).transpose(1, 0, 3, 2, 4)

    causal = jnp.tril(jnp.ones((C, C), dtype=bool))

    def step(S, inp):
        qc, kc, vc, gc = inp
        b = jnp.cumsum(gc, axis=2)
        b_last = b[:, :, -1:, :]
        q_s = qc * jnp.exp(b)
        k_s = kc * jnp.exp(-b)
        k_end = kc * jnp.exp(b_last - b)
        att = jnp.where(causal, jnp.einsum('bhik,bhjk->bhij', q_s, k_s), 0.0)
        o = jnp.einsum('bhik,bhkv->bhiv', q_s, S) + jnp.einsum('bhij,bhjv->bhiv', att, vc)
        S = jnp.swapaxes(jnp.exp(b_last), -1, -2) * S + jnp.einsum('bhjk,bhjv->bhkv', k_end, vc)
        return S, o

    S, o = lax.scan(step, S0.astype(jnp.float32), (to_chunks(q), to_chunks(k), to_chunks(v), to_chunks(g)))
    o = o.transpose(1, 0, 3, 2, 4).reshape(B, L, H, GLA_DV)
    return o, S


def mixer(hn, conv_buf, h0, S0, pos, n_meta, w_in, conv_w, conv_b, wa, ba, wx, bx, lam,
          w_gate2, b_gate, gla_norm, w_out):
    B, L, _ = hn.shape
    u = hn @ w_in
    hk = GLA_HEADS * GLA_DK
    hv = GLA_HEADS * GLA_DV
    splits = [D_LRU, 2 * D_LRU, 2 * D_LRU + hk, 2 * D_LRU + 2 * hk,
              2 * D_LRU + 2 * hk + hv, 2 * D_LRU + 2 * hk + 2 * hv]
    xl, gl, q, k, v, go, lr = jnp.split(u, splits, axis=-1)
    xc, new_buf = causal_conv(xl, conv_buf, conv_w, conv_b)
    h, h_last = rg_lru(xc, h0, pos, wa, ba, wx, bx, lam)
    lru_out = h * jax.nn.gelu(gl)
    q = q.reshape(B, L, GLA_HEADS, GLA_DK) * (GLA_DK ** -0.5)
    k = k.reshape(B, L, GLA_HEADS, GLA_DK)
    v = v.reshape(B, L, GLA_HEADS, GLA_DV)
    g = jax.nn.log_sigmoid((lr @ w_gate2 + b_gate).astype(jnp.float32)) / GLA_GATE_NORM
    g = g.reshape(B, L, GLA_HEADS, GLA_DK)
    if n_meta > 0:
        o_m, S = gla_chunked(q[:, :n_meta], k[:, :n_meta], v[:, :n_meta], g[:, :n_meta], S0)
        o_r, S = gla_chunked(q[:, n_meta:], k[:, n_meta:], v[:, n_meta:], g[:, n_meta:], S)
        o = jnp.concatenate([o_m, o_r], axis=1)
    else:
        o, S = gla_chunked(q, k, v, g, S0)
    o = rmsnorm(o.astype(hn.dtype), gla_norm).reshape(B, L, hv)
    gla_out = o * jax.nn.silu(go)
    y = jnp.concatenate([lru_out, gla_out], axis=-1) @ w_out
    return y, new_buf, h_last, S.astype(hn.dtype)


def run_trunk(x, conv0, h0, S0, pos, n_meta, weights):
    (norm_ffn1, w_ffn1_gu, w_ffn1_down, norm_mix, w_in, lru_conv_w, lru_conv_b,
     lru_wa, lru_ba, lru_wx, lru_bx, lru_lambda, gla_w_gate2, gla_b_gate, gla_norm,
     w_out, norm_ffn2, w_ffn2_gu, w_ffn2_down, norm_final) = weights
    convs, hs, Ss = [], [], []
    for l in range(DEPTH):
        x = x + 0.5 * swiglu(rmsnorm(x, norm_ffn1[l]), w_ffn1_gu[l], w_ffn1_down[l])
        m, cb, hl, S = mixer(rmsnorm(x, norm_mix[l]), conv0[l], h0[l], S0[l], pos, n_meta,
                             w_in[l], lru_conv_w[l], lru_conv_b[l], lru_wa[l], lru_ba[l],
                             lru_wx[l], lru_bx[l], lru_lambda[l], gla_w_gate2[l], gla_b_gate[l],
                             gla_norm[l], w_out[l])
        x = x + m
        x = x + 0.5 * swiglu(rmsnorm(x, norm_ffn2[l]), w_ffn2_gu[l], w_ffn2_down[l])
        convs.append(cb)
        hs.append(hl)
        Ss.append(S)
    return rmsnorm(x, norm_final), jnp.stack(hs), jnp.stack(convs), jnp.stack(Ss)


def setup_inputs(seed: int = 0) -> dict:
    key = jax.random.key(seed)
    ks = jax.random.split(key, 40)
    f32 = jnp.float32

    def nrm(k, shape, scale):
        return jax.random.normal(k, shape, f32) * scale

    a0 = jax.random.uniform(ks[14], (DEPTH, D_LRU), f32, minval=0.9, maxval=0.999)
    return {
        "x_prompt": nrm(ks[0], (BATCH, SEQ, D_MODEL), 1.0),
        "x_sample": nrm(ks[1], (DEC_BATCH, DEC_SEQ, D_MODEL), 1.0),
        "state_lru_h": nrm(ks[2], (DEPTH, DEC_BATCH, D_LRU), 0.5),
        "state_lru_conv": nrm(ks[3], (DEPTH, DEC_BATCH, CONV_W - 1, D_LRU), 1.0),
        "state_gla_S": nrm(ks[4], (DEPTH, DEC_BATCH, GLA_HEADS, GLA_DK, GLA_DV), 0.3),
        "meta": nrm(ks[5], (N_META, D_MODEL), 1.0),
        "norm_ffn1": 1.0 + nrm(ks[6], (DEPTH, D_MODEL), 0.02),
        "w_ffn1_gu": nrm(ks[7], (DEPTH, D_MODEL, 2 * D_FF), D_MODEL ** -0.5),
        "w_ffn1_down": nrm(ks[8], (DEPTH, D_FF, D_MODEL), D_FF ** -0.5),
        "norm_mix": 1.0 + nrm(ks[9], (DEPTH, D_MODEL), 0.02),
        "w_in": nrm(ks[10], (DEPTH, D_MODEL, D_IN), D_MODEL ** -0.5),
        "lru_conv_w": nrm(ks[11], (DEPTH, CONV_W, D_LRU), CONV_W ** -0.5),
        "lru_conv_b": nrm(ks[12], (DEPTH, D_LRU), 0.01),
        "lru_wa": nrm(ks[13], (DEPTH, LRU_BLOCKS, LRU_BW, LRU_BW), LRU_BW ** -0.5),
        "lru_ba": nrm(ks[15], (DEPTH, D_LRU), 0.01),
        "lru_wx": nrm(ks[16], (DEPTH, LRU_BLOCKS, LRU_BW, LRU_BW), LRU_BW ** -0.5),
        "lru_bx": nrm(ks[17], (DEPTH, D_LRU), 0.01),
        "lru_lambda": jnp.log(a0) - jnp.log1p(-a0),
        "gla_w_gate2": nrm(ks[18], (DEPTH, GLA_RANK, GLA_HEADS * GLA_DK), GLA_RANK ** -0.5),
        "gla_b_gate": nrm(ks[19], (DEPTH, GLA_HEADS * GLA_DK), 0.1),
        "gla_norm": 1.0 + nrm(ks[20], (DEPTH, GLA_DV), 0.02),
        "w_out": nrm(ks[21], (DEPTH, D_MIX, D_MODEL), D_MIX ** -0.5),
        "norm_ffn2": 1.0 + nrm(ks[22], (DEPTH, D_MODEL), 0.02),
        "w_ffn2_gu": nrm(ks[23], (DEPTH, D_MODEL, 2 * D_FF), D_MODEL ** -0.5),
        "w_ffn2_down": nrm(ks[24], (DEPTH, D_FF, D_MODEL), D_FF ** -0.5),
        "norm_final": 1.0 + nrm(ks[25], (D_MODEL,), 0.02),
    }


def reference(x_prompt, x_sample, state_lru_h, state_lru_conv, state_gla_S, meta,
              norm_ffn1, w_ffn1_gu, w_ffn1_down, norm_mix, w_in, lru_conv_w, lru_conv_b,
              lru_wa, lru_ba, lru_wx, lru_bx, lru_lambda, gla_w_gate2, gla_b_gate, gla_norm,
              w_out, norm_ffn2, w_ffn2_gu, w_ffn2_down, norm_final):
    weights = (norm_ffn1, w_ffn1_gu, w_ffn1_down, norm_mix, w_in, lru_conv_w, lru_conv_b,
               lru_wa, lru_ba, lru_wx, lru_bx, lru_lambda, gla_w_gate2, gla_b_gate, gla_norm,
               w_out, norm_ffn2, w_ffn2_gu, w_ffn2_down, norm_final)
    B, S_len, D = x_prompt.shape
    xp = jnp.concatenate([jnp.broadcast_to(meta.astype(x_prompt.dtype), (B, N_META, D)), x_prompt], axis=1)
    pos_p = jnp.arange(N_META + S_len)
    conv0 = jnp.zeros((DEPTH, B, CONV_W - 1, D_LRU), x_prompt.dtype)
    h0 = jnp.zeros((DEPTH, B, D_LRU), x_prompt.dtype)
    S0 = jnp.zeros((DEPTH, B, GLA_HEADS, GLA_DK, GLA_DV), x_prompt.dtype)
    yp, h_p, conv_p, S_p = run_trunk(xp, conv0, h0, S0, pos_p, N_META, weights)
    y_prompt = yp[:, N_META:]
    pos_s = PAST_LEN + jnp.arange(x_sample.shape[1])
    y_sample, h_s, conv_s, S_s = run_trunk(x_sample, state_lru_conv, state_lru_h, state_gla_S,
                                           pos_s, 0, weights)
    return (y_prompt, y_sample, h_p, conv_p, S_p, h_s, conv_s, S_s)
```

```cpp
#include <hip/hip_runtime.h>
#include <hip/hip_cooperative_groups.h>
#include <cstdio>
#include <cstdint>
namespace cg = cooperative_groups;

#define DI __device__ __forceinline__
#define LAS __attribute__((address_space(3)))
typedef unsigned short bf16_t;
typedef short bf16x8 __attribute__((ext_vector_type(8)));
typedef float f32x4 __attribute__((ext_vector_type(4)));
typedef float f32x16 __attribute__((ext_vector_type(16)));
typedef unsigned u32x4 __attribute__((ext_vector_type(4)));
typedef unsigned u32x2 __attribute__((ext_vector_type(2)));

constexpr int DM = 1024, NB = 8, SEQ = 2048, NMETA = 16, LP = SEQ + NMETA, NSB = 128, LS = 8;
constexpr int MP = NB * LP;
constexpr int MS = NSB * LS;
constexpr int MTOK = MP + MS;
constexpr int MPAD = 17664;
constexpr int DFF = 2816, DLRU = 512, NH = 4, DK = 64, DV = 128, DIN = 2576, UN = 2816;
constexpr int NCH = 33, NUNIT_P = NB * NCH, NUNIT = NUNIT_P + NSB;
constexpr int U_XL = 0, U_GL = 512, U_Q = 1024, U_K = 1280, U_V = 1536, U_GO = 2048, U_LR = 2560;
constexpr float EPS = 1e-6f;
constexpr size_t O_YP = 0, O_YS = 16777216, O_HP = 17825792, O_CP = 17833984, O_SP = 17858560, O_HS = 18382848, O_CS = 18513920, O_SS = 18907136;
constexpr size_t MiB = 1u << 20;
constexpr size_t WS_SS = 1 * MiB;
constexpr size_t WS_WAT = 1 * MiB + 512 * 1024;
constexpr size_t WS_FLAGS = 16384;
constexpr size_t WS_LFLAG = 32768;
constexpr size_t WS_LSUM = 2 * MiB;
constexpr size_t WS_DBUF = 3 * MiB + 512 * 1024;
constexpr size_t WS_WGU1 = 4 * MiB, WS_WD1 = 15 * MiB, WS_WIN = 20 * MiB + 512 * 1024, WS_WOUT = 26 * MiB, WS_WGU2 = 28 * MiB, WS_WD2 = 39 * MiB;
constexpr size_t WS_XB = 45 * MiB, WS_HU = 80 * MiB, WS_Y = 175 * MiB, WS_SB = 210 * MiB, WS_END = 243 * MiB;
constexpr int LDS_BYTES = 147456;

DI float bf2f(unsigned v) { return __uint_as_float(v << 16); }
DI unsigned cvt_pk(float lo, float hi) { unsigned r; asm("v_cvt_pk_bf16_f32 %0, %1, %2" : "=v"(r) : "v"(lo), "v"(hi)); return r; }
DI bf16_t f2bf(float f) { return (bf16_t)(cvt_pk(f, 0.f) & 0xffffu); }
DI float rcpf(float x) { return __builtin_amdgcn_rcpf(x); }
DI float sigmoidf_(float x) { return rcpf(1.f + __expf(-x)); }
DI float siluf_(float x) { return x * sigmoidf_(x); }
DI float gelu_tanh(float x) { const float u = 0.7978845608028654f * (x + 0.044715f * x * x * x); return x * sigmoidf_(2.f * u); }
DI void unpack8(const u32x4 v, float* f) {
    f[0] = bf2f(v.x & 0xffffu); f[1] = __uint_as_float(v.x & 0xffff0000u); f[2] = bf2f(v.y & 0xffffu); f[3] = __uint_as_float(v.y & 0xffff0000u);
    f[4] = bf2f(v.z & 0xffffu); f[5] = __uint_as_float(v.z & 0xffff0000u); f[6] = bf2f(v.w & 0xffffu); f[7] = __uint_as_float(v.w & 0xffff0000u);
}
DI float wave_sum(float v) {
#pragma unroll
    for (int o = 1; o < 64; o <<= 1) v += __shfl_xor(v, o);
    return v;
}
#define LDS_WAIT() asm volatile("s_waitcnt lgkmcnt(0)" ::: "memory")
#define LBAR() do { asm volatile("s_waitcnt lgkmcnt(0)" ::: "memory"); __builtin_amdgcn_s_barrier(); asm volatile("" ::: "memory"); } while (0)

namespace pg8 {
#define PG8_LAS __attribute__((address_space(3)))
constexpr int BM = 256, BK = 64, HALF = 128, HTB = HALF * BK * 2, STAGE_BYTES = 8 * HTB, NXCD = 8, WGM = 8;
__host__ __device__ __forceinline__ int lds_byte(int r, int c) { const int st = (r >> 4) * 2 + (c >> 5), rr = r & 15, cc = c & 31, ob = rr * 64 + cc * 2; return st * 1024 + (ob ^ (((ob >> 9) & 1) << 5)); }
__host__ __device__ __forceinline__ void stage_rc(int b, int& R, int& C) { const int st = b / 1024, sb = b % 1024, swz = sb ^ (((sb >> 9) & 1) << 5); R = (st >> 1) * 16 + swz / 64; C = (st & 1) * 32 + (swz % 64) / 2; }
__host__ __device__ __forceinline__ int perm32(int rho) { const int n = rho >> 4, i = rho & 15; return 8 * (i >> 2) + 4 * n + (i & 3); }
struct Unit { int pm, pn, kt0, nkt, kind, slot; };
struct Gemm { const bf16_t* A; const bf16_t* Bt; int M, N, K; };
struct StaticOrder {
    int nM, nN, nwg, G, c, nktf;
    __host__ __device__ void init(int M, int N, int K, int G_, int c_) { nM = M / BM; nN = N / BM; nwg = nM * nN; G = G_; c = c_; nktf = K / BK; }
    __host__ __device__ bool next(int i, Unit& u) const {
        const long L = (long)i * G + c; if (L >= nwg) return false;
        int wgid = (int)L; { const int q = nwg / NXCD, r = nwg % NXCD, xcd = wgid % NXCD, off = wgid / NXCD; wgid = (xcd < r ? xcd * (q + 1) : r * (q + 1) + (xcd - r) * q) + off; }
        const int nig = WGM * nN, gid = wgid / nig, fm = gid * WGM, gsz = (nM - fm) < WGM ? (nM - fm) : WGM;
        u.pm = fm + ((wgid % nig) % gsz); u.pn = (wgid % nig) / gsz; u.kt0 = 0; u.nkt = nktf; u.kind = 0; u.slot = 0; return true;
    }
    __device__ __forceinline__ void a_ready(const Unit&) const {}
    __device__ __forceinline__ void done(const Unit&) const {}
};

struct SKOrder {
    int P, s, e, v;
    __device__ void init(int K, int G, int v_) { P = K / (2 * BK); const long total = (long)276 * P; s = (int)(total * v_ / G); e = (int)(total * (v_ + 1) / G); v = v_; }
    __device__ bool next(int i, Unit& u) const {
        int pe = e;
        for (int k = 0;; ++k) {
            if (pe <= s) return false;
            const int un = (pe - 1) / P, ps = (s > un * P) ? s : un * P;
            if (k == i) { u.pm = un >> 2; u.pn = un & 3; u.kt0 = 2 * (ps - un * P); u.nkt = 2 * (pe - ps);
                u.kind = (pe - ps == P) ? 0 : (ps == un * P ? 1 : 2); u.slot = (u.kind == 1) ? v : v - 1; return true; }
            pe = ps;
        }
    }
    __device__ __forceinline__ void a_ready(const Unit&) const {}
    __device__ __forceinline__ void done(const Unit&) const {}
};

template <class Epi, class Sched, bool ALIGN_EPI = false, bool SP2 = false>
__device__ __forceinline__ void gemm_phase(PG8_LAS unsigned char* lds, const Gemm g, const Sched& S, const Epi& E) {
    int tid_ = threadIdx.x; asm volatile("" : "+v"(tid_));
    const int tid = tid_, wid = __builtin_amdgcn_readfirstlane(tid >> 6), lane = tid & 63, wr = wid >> 2, wc = wid & 3, fr = lane & 15, fq = lane >> 4;
    const int K = g.K;
    unsigned voffA[2], voffB[2];
#pragma unroll
    for (int i = 0; i < 2; ++i) { int R, C; stage_rc(tid * 16 + i * 8192, R, C); const int Rb = Epi::PERM ? ((R & ~31) + perm32(R & 31)) : R;
        voffA[i] = (unsigned)(R * K + C) * 2u; voffB[i] = (unsigned)(Rb * K + C) * 2u; }
    const size_t kstep = (size_t)(BK * 2);
    const size_t hstep = (size_t)HALF * K * 2;
    const size_t tstep = 2 * hstep;
    const unsigned ldsw = (unsigned)wid * 1024u;
    const int aoff = lds_byte(wr * 64 + fr, fq * 8), boff = lds_byte(wc * 32 + fr, fq * 8);
#define PG8_SA(b, h) (((b) * 2 + (h)) * HTB)
#define PG8_SB(b, h) ((4 + (b) * 2 + (h)) * HTB)
#define PG8_STAGE(bufoff, gbase, voff) do { _Pragma("unroll") for (int _i = 0; _i < 2; ++_i) \
        __builtin_amdgcn_global_load_lds((const unsigned*)((const char*)(gbase) + (voff)[_i]), (PG8_LAS unsigned*)(lds + (bufoff) + ldsw + _i * 8192), 16, 0, 0); } while (0)
#define PG8_LDA(dst, b, h) do { _Pragma("unroll") for (int m = 0; m < 4; ++m) _Pragma("unroll") for (int k = 0; k < 2; ++k) dst[m][k] = *(const PG8_LAS bf16x8*)(lds + PG8_SA(b, h) + aoff + m * 2048 + k * 1024); } while (0)
#define PG8_LDB(dst, b, h) do { _Pragma("unroll") for (int n = 0; n < 2; ++n) _Pragma("unroll") for (int k = 0; k < 2; ++k) dst[n][k] = *(const PG8_LAS bf16x8*)(lds + PG8_SB(b, h) + boff + n * 2048 + k * 1024); } while (0)
#define PG8_MMA(ai, bj, At, Bt) do { __builtin_amdgcn_s_setprio(1); _Pragma("unroll") for (int m = 0; m < 4; ++m) _Pragma("unroll") for (int n = 0; n < 2; ++n) _Pragma("unroll") for (int k = 0; k < 2; ++k) \
        acc[ai][bj][m][n] = __builtin_amdgcn_mfma_f32_16x16x32_bf16(Bt[n][k], At[m][k], acc[ai][bj][m][n], 0, 0, 0); __builtin_amdgcn_s_setprio(0); } while (0)
#define PG8_WAIT_V(n) asm volatile("s_waitcnt vmcnt(" #n ")" ::: "memory")
#define PG8_WAIT_L(n) asm volatile("s_waitcnt lgkmcnt(" #n ")" ::: "memory")
#define PG8_BAR __builtin_amdgcn_s_barrier()
#define PG8_SCHED __builtin_amdgcn_sched_barrier(0)
    Unit cur, nxt; int ui = 0;
    if (!S.next(0, cur)) return;
    f32x4 acc[2][2][4][2];
#pragma unroll
    for (int a = 0; a < 2; ++a)
#pragma unroll
        for (int b = 0; b < 2; ++b)
#pragma unroll
            for (int m = 0; m < 4; ++m)
#pragma unroll
                for (int n = 0; n < 2; ++n) acc[a][b][m][n] = (f32x4){0.f, 0.f, 0.f, 0.f};
    bf16x8 At[4][2], B0[2][2], B1[2][2];
    const char* cA = (const char*)g.A + (size_t)cur.pm * tstep + (size_t)cur.kt0 * kstep; const char* cB = (const char*)g.Bt + (size_t)cur.pn * tstep + (size_t)cur.kt0 * kstep;
    S.a_ready(cur);
    if constexpr (SP2) {
        PG8_STAGE(PG8_SB(0, 0), cB, voffB); PG8_STAGE(PG8_SB(0, 1), cB + hstep, voffB); PG8_STAGE(PG8_SA(0, 0), cA, voffA); PG8_STAGE(PG8_SA(0, 1), cA + hstep, voffA);
        if (wr == 1) PG8_BAR;
        PG8_WAIT_V(2); PG8_BAR;
        PG8_STAGE(PG8_SB(1, 0), cB + kstep, voffB); PG8_STAGE(PG8_SA(1, 0), cA + kstep, voffA); PG8_STAGE(PG8_SB(1, 1), cB + hstep + kstep, voffB);
        PG8_WAIT_V(6); PG8_BAR;
    } else {
        PG8_STAGE(PG8_SB(0, 0), cB, voffB); PG8_STAGE(PG8_SA(0, 0), cA, voffA); PG8_STAGE(PG8_SB(0, 1), cB + hstep, voffB); PG8_STAGE(PG8_SA(0, 1), cA + hstep, voffA);
        if (wr == 1) PG8_BAR;
        PG8_WAIT_V(4); PG8_BAR;
        PG8_STAGE(PG8_SB(1, 0), cB + kstep, voffB); PG8_STAGE(PG8_SA(1, 0), cA + kstep, voffA); PG8_STAGE(PG8_SB(1, 1), cB + hstep + kstep, voffB);
        PG8_WAIT_V(6); PG8_BAR;
    }
    for (;;) {
        const bool has_next = S.next(ui + 1, nxt);
        const char* nA = has_next ? (const char*)g.A + (size_t)nxt.pm * tstep + (size_t)nxt.kt0 * kstep : cA; const char* nB = has_next ? (const char*)g.Bt + (size_t)nxt.pn * tstep + (size_t)nxt.kt0 * kstep : cB;
        const int nt = cur.nkt;
        for (int t = 0; t < nt; t += 2) {
            const bool last = (t == nt - 2);
            const char* a1 = cA + (size_t)(t + 1) * kstep;
            const char* a2 = last ? nA : cA + (size_t)(t + 2) * kstep; const char* b2 = last ? nB : cB + (size_t)(t + 2) * kstep;
            const char* a3 = a2 + kstep; const char* b3 = b2 + kstep;
            if (last && has_next) S.a_ready(nxt);
            if constexpr (SP2) {
            PG8_LDB(B0, 0, 0); PG8_LDB(B1, 0, 1); PG8_SCHED; PG8_LDA(At, 0, 0); PG8_STAGE(PG8_SA(1, 1), a1 + hstep, voffA);
            PG8_WAIT_V(8); PG8_WAIT_L(0); PG8_BAR; PG8_MMA(0, 0, At, B0); PG8_MMA(0, 1, At, B1); PG8_BAR; PG8_SCHED;
            PG8_LDA(At, 0, 1); PG8_STAGE(PG8_SB(0, 0), b2, voffB); PG8_STAGE(PG8_SB(0, 1), b2 + hstep, voffB); PG8_STAGE(PG8_SA(0, 0), a2, voffA);
            PG8_WAIT_V(8); PG8_WAIT_L(0); PG8_BAR; PG8_MMA(1, 0, At, B0); PG8_MMA(1, 1, At, B1); PG8_BAR; PG8_SCHED;
            PG8_LDB(B0, 1, 0); PG8_LDB(B1, 1, 1); PG8_SCHED; PG8_LDA(At, 1, 0); PG8_STAGE(PG8_SA(0, 1), a2 + hstep, voffA);
            PG8_WAIT_V(8); PG8_WAIT_L(0); PG8_BAR; PG8_MMA(0, 0, At, B0); PG8_MMA(0, 1, At, B1); PG8_BAR; PG8_SCHED;
            PG8_LDA(At, 1, 1); PG8_STAGE(PG8_SB(1, 0), b3, voffB); PG8_STAGE(PG8_SB(1, 1), b3 + hstep, voffB); PG8_STAGE(PG8_SA(1, 0), a3, voffA);
            PG8_WAIT_V(8); PG8_WAIT_L(0); PG8_BAR; PG8_MMA(1, 0, At, B0); PG8_MMA(1, 1, At, B1); PG8_BAR; PG8_SCHED;
            } else {
            PG8_LDB(B0, 0, 0); PG8_SCHED; PG8_LDA(At, 0, 0); PG8_STAGE(PG8_SA(1, 1), a1 + hstep, voffA);
            PG8_WAIT_L(8); PG8_BAR; PG8_WAIT_L(0); PG8_MMA(0, 0, At, B0); PG8_BAR; PG8_SCHED;
            PG8_LDB(B1, 0, 1); PG8_STAGE(PG8_SB(0, 0), b2, voffB);
            PG8_BAR; PG8_WAIT_L(0); PG8_MMA(0, 1, At, B1); PG8_BAR;
            PG8_LDA(At, 0, 1); PG8_STAGE(PG8_SA(0, 0), a2, voffA);
            PG8_BAR; PG8_WAIT_L(0); PG8_MMA(1, 0, At, B0); PG8_BAR; PG8_SCHED;
            PG8_STAGE(PG8_SB(0, 1), b2 + hstep, voffB);
            PG8_WAIT_V(6); PG8_BAR; PG8_MMA(1, 1, At, B1); PG8_BAR;
            PG8_LDB(B0, 1, 0); PG8_SCHED; PG8_LDA(At, 1, 0); PG8_STAGE(PG8_SA(0, 1), a2 + hstep, voffA);
            PG8_WAIT_L(8); PG8_BAR; PG8_WAIT_L(0); PG8_MMA(0, 0, At, B0); PG8_BAR; PG8_SCHED;
            PG8_LDB(B1, 1, 1); PG8_STAGE(PG8_SB(1, 0), b3, voffB);
            PG8_BAR; PG8_WAIT_L(0); PG8_MMA(0, 1, At, B1); PG8_BAR;
            PG8_LDA(At, 1, 1); PG8_STAGE(PG8_SA(1, 0), a3, voffA);
            PG8_BAR; PG8_WAIT_L(0); PG8_MMA(1, 0, At, B0); PG8_BAR; PG8_SCHED;
            PG8_STAGE(PG8_SB(1, 1), b3 + hstep, voffB);
            PG8_WAIT_V(6); PG8_BAR; PG8_MMA(1, 1, At, B1); PG8_BAR;
            }
        }
        if constexpr (ALIGN_EPI) { if (wr == 0) PG8_BAR; }
        E(acc, cur, wr, wc, fr, fq); S.done(cur);
        if (!has_next) break;
#pragma unroll
        for (int a = 0; a < 2; ++a)
#pragma unroll
            for (int b = 0; b < 2; ++b)
#pragma unroll
                for (int m = 0; m < 4; ++m)
#pragma unroll
                    for (int n = 0; n < 2; ++n) acc[a][b][m][n] = (f32x4){0.f, 0.f, 0.f, 0.f};
        cur = nxt; cA = nA; cB = nB; ++ui;
        if constexpr (ALIGN_EPI) { if (wr == 1) PG8_BAR; }
    }
    PG8_WAIT_V(0);
    if constexpr (!ALIGN_EPI) { if (wr == 0) PG8_BAR; }
    PG8_BAR;
#undef PG8_SA
#undef PG8_SB
#undef PG8_STAGE
#undef PG8_LDA
#undef PG8_LDB
#undef PG8_MMA
#undef PG8_WAIT_V
#undef PG8_WAIT_L
#undef PG8_BAR
#undef PG8_SCHED
}

struct EpiSwiGLU {
    static constexpr bool PERM = true;
    bf16_t* H; const float* ss;
    static __device__ __forceinline__ EpiSwiGLU make(unsigned char* ws, int ssi) { return EpiSwiGLU{(bf16_t*)(ws + WS_HU), (const float*)(ws + WS_SS) + (size_t)ssi * MPAD}; }
    __device__ __forceinline__ void operator()(const f32x4 (&acc)[2][2][4][2], const Unit& u, int wr, int wc, int fr, int fq) const {
        const int row0 = u.pm * BM + wr * 64 + fr, col0 = u.pn * 128 + wc * 32 + 8 * fq;
#pragma unroll
        for (int ai = 0; ai < 2; ++ai)
#pragma unroll
            for (int m = 0; m < 4; ++m) {
                const int row = row0 + ai * HALF + m * 16;
                const float rs = rsqrtf(ss[row] * (1.f / DM) + EPS);
                float h[8];
#pragma unroll
                for (int n = 0; n < 2; ++n)
#pragma unroll
                    for (int j = 0; j < 4; ++j) { const float gg = acc[ai][0][m][n][j] * rs, uu = acc[ai][1][m][n][j] * rs; h[4 * n + j] = siluf_(gg) * uu; }
                u32x4 w; w.x = cvt_pk(h[0], h[1]); w.y = cvt_pk(h[2], h[3]); w.z = cvt_pk(h[4], h[5]); w.w = cvt_pk(h[6], h[7]);
                *(u32x4*)(H + (size_t)row * DFF + col0) = w;
            }
    }
};
struct EpiRowScale {
    static constexpr bool PERM = true;
    bf16_t* O; int ldc; const float* ss;
    static __device__ __forceinline__ EpiRowScale make(unsigned char* ws, int ssi) { return EpiRowScale{(bf16_t*)(ws + WS_HU), UN, (const float*)(ws + WS_SS) + (size_t)ssi * MPAD}; }
    __device__ __forceinline__ void operator()(const f32x4 (&acc)[2][2][4][2], const Unit& u, int wr, int wc, int fr, int fq) const {
        const int row0 = u.pm * BM + wr * 64 + fr, col0 = u.pn * BM + wc * 32 + 8 * fq;
#pragma unroll
        for (int ai = 0; ai < 2; ++ai)
#pragma unroll
            for (int m = 0; m < 4; ++m) {
                const int row = row0 + ai * HALF + m * 16;
                const float rs = rsqrtf(ss[row] * (1.f / DM) + EPS);
#pragma unroll
                for (int bj = 0; bj < 2; ++bj) {
                    const f32x4 v0 = acc[ai][bj][m][0] * rs, v1 = acc[ai][bj][m][1] * rs;
                    u32x4 w; w.x = cvt_pk(v0[0], v0[1]); w.y = cvt_pk(v0[2], v0[3]); w.z = cvt_pk(v1[0], v1[1]); w.w = cvt_pk(v1[2], v1[3]);
                    *(u32x4*)(O + (size_t)row * ldc + col0 + bj * HALF) = w;
                }
            }
    }
};
struct EpiRes {
    static constexpr bool PERM = true;
    bf16_t* X; float* ssn; float scale; float* part; unsigned* flags; unsigned epoch;
    static __device__ __forceinline__ EpiRes make(unsigned char* ws, int ssi, float sc, size_t part_off, unsigned ep) {
        return EpiRes{(bf16_t*)(ws + WS_XB), (float*)(ws + WS_SS) + (size_t)ssi * MPAD, sc, (float*)(ws + part_off), (unsigned*)(ws + WS_FLAGS), ep}; }
    __device__ __forceinline__ void operator()(const f32x4 (&acc)[2][2][4][2], const Unit& u, int wr, int wc, int fr, int fq) const {
        const int wid = wr * 4 + wc, lane = fr + 16 * fq;
        if (u.kind == 1) {
            const u32x4* dst = (const u32x4*)(part + (size_t)u.slot * 32768) + (size_t)wid * 1024 + lane;
#pragma unroll
            for (int ai = 0; ai < 2; ++ai)
#pragma unroll
                for (int bj = 0; bj < 2; ++bj)
#pragma unroll
                    for (int m = 0; m < 4; ++m) { const int c = (ai * 2 + bj) * 4 + m; const f32x4 a0 = acc[ai][bj][m][0], a1 = acc[ai][bj][m][1];
                        u32x4 w; w.x = cvt_pk(a0[0], a0[1]); w.y = cvt_pk(a0[2], a0[3]); w.z = cvt_pk(a1[0], a1[1]); w.w = cvt_pk(a1[2], a1[3]);
                        asm volatile("global_store_dwordx4 %0, %1, off sc1" :: "v"(dst + c * 64), "v"(w) : "memory"); }
            asm volatile("s_waitcnt vmcnt(0)" ::: "memory");
            __syncthreads();
            if (wid == 0 && lane == 0) __hip_atomic_store(flags + u.slot * 16, epoch, __ATOMIC_RELAXED, __HIP_MEMORY_SCOPE_AGENT);
            return;
        }
        const u32x4* src = nullptr;
        if (u.kind == 2) {
            if (wid == 0 && lane == 0) { unsigned sp = 0; while (__hip_atomic_load(flags + u.slot * 16, __ATOMIC_RELAXED, __HIP_MEMORY_SCOPE_AGENT) != epoch) { __builtin_amdgcn_s_sleep(2); if (++sp > (1u << 22)) break; } }
            __syncthreads();
            src = (const u32x4*)(part + (size_t)u.slot * 32768) + (size_t)wid * 1024 + lane;
        }
        const int row0 = u.pm * BM + wr * 64 + fr, col0 = u.pn * BM + wc * 32 + 8 * fq;
#pragma unroll
        for (int ai = 0; ai < 2; ++ai)
#pragma unroll
            for (int mp = 0; mp < 2; ++mp) {
                u32x4 xin[2][2];
#pragma unroll
                for (int mm = 0; mm < 2; ++mm)
#pragma unroll
                    for (int bj = 0; bj < 2; ++bj) xin[mm][bj] = *(const u32x4*)(X + (size_t)(row0 + ai * HALF + (mp * 2 + mm) * 16) * DM + col0 + bj * HALF);
                f32x4 pv[2][2][2];
#pragma unroll
                for (int mm = 0; mm < 2; ++mm)
#pragma unroll
                    for (int bj = 0; bj < 2; ++bj)
#pragma unroll
                        for (int n = 0; n < 2; ++n) pv[mm][bj][n] = (f32x4){0.f, 0.f, 0.f, 0.f};
                if (src) {
                    u32x4 pc[2][2];
#define CI(mm, bj) ((((ai * 2 + (bj)) * 4 + mp * 2 + (mm))) * 64)
                    asm volatile("global_load_dwordx4 %0, %4, off sc1\n\tglobal_load_dwordx4 %1, %5, off sc1\n\tglobal_load_dwordx4 %2, %6, off sc1\n\tglobal_load_dwordx4 %3, %7, off sc1\n\ts_waitcnt vmcnt(0)"
                                 : "=&v"(pc[0][0]), "=&v"(pc[0][1]), "=&v"(pc[1][0]), "=&v"(pc[1][1])
                                 : "v"(src + CI(0, 0)), "v"(src + CI(0, 1)), "v"(src + CI(1, 0)), "v"(src + CI(1, 1))
                                 : "memory");
#undef CI
#pragma unroll
                    for (int mm = 0; mm < 2; ++mm)
#pragma unroll
                        for (int bj = 0; bj < 2; ++bj) { float f[8]; unpack8(pc[mm][bj], f); pv[mm][bj][0] = (f32x4){f[0], f[1], f[2], f[3]}; pv[mm][bj][1] = (f32x4){f[4], f[5], f[6], f[7]}; }
                }
#pragma unroll
                for (int mm = 0; mm < 2; ++mm) {
                    const int m = mp * 2 + mm;
                    const int row = row0 + ai * HALF + m * 16;
                    float s = 0.f;
#pragma unroll
                    for (int bj = 0; bj < 2; ++bj) {
                        u32x4* px = (u32x4*)(X + (size_t)row * DM + col0 + bj * HALF);
                        float xo[8]; unpack8(xin[mm][bj], xo);
                        const f32x4 a0 = acc[ai][bj][m][0] + pv[mm][bj][0], a1 = acc[ai][bj][m][1] + pv[mm][bj][1];
                        u32x4 w;
                        w.x = cvt_pk(xo[0] + scale * a0[0], xo[1] + scale * a0[1]); w.y = cvt_pk(xo[2] + scale * a0[2], xo[3] + scale * a0[3]);
                        w.z = cvt_pk(xo[4] + scale * a1[0], xo[5] + scale * a1[1]); w.w = cvt_pk(xo[6] + scale * a1[2], xo[7] + scale * a1[3]);
                        *px = w;
                        float xn[8]; unpack8(w, xn);
#pragma unroll
                        for (int j = 0; j < 8; ++j) s += xn[j] * xn[j];
                    }
                    s += __shfl_xor(s, 16); s += __shfl_xor(s, 32);
                    if (fq == 0) unsafeAtomicAdd(ssn + row, s);
                }
            }
    }
};
}

struct Args { const float* in[26]; float* out; unsigned char* ws; };
typedef const __attribute__((address_space(4))) Args* KA;
DI KA get_ka() { KA p = (KA)__builtin_amdgcn_kernarg_segment_ptr(); asm volatile("" : "+s"(p)); return p; }
DI int opaque_tid() { int t = threadIdx.x; asm volatile("" : "+v"(t)); return t; }

template <int MODE  >
DI void transpose_item(const float* __restrict__ W, const float* __restrict__ gk, int K, int N, bf16_t* WT, LAS float* scr, int item, int lane) {
    const int nblk = (N + 31) / 32, kb = item / nblk, nb = item % nblk, k0 = 64 * kb, n0 = 32 * nb;
    const int kr = lane >> 3, c4 = (lane & 7) * 4;
    f32x4 wv[8];
#pragma unroll
    for (int i = 0; i < 8; ++i) wv[i] = (n0 + c4 < N) ? __builtin_nontemporal_load((const f32x4*)(W + (size_t)(k0 + 8 * i + kr) * N + n0 + c4)) : (f32x4){0.f, 0.f, 0.f, 0.f};
    if (gk) {
#pragma unroll
        for (int i = 0; i < 8; ++i) wv[i] = wv[i] * gk[k0 + 8 * i + kr];
    }
#pragma unroll
    for (int i = 0; i < 8; ++i) { LAS float* d = scr + (8 * i + kr) * 33 + c4; d[0] = wv[i].x; d[1] = wv[i].y; d[2] = wv[i].z; d[3] = wv[i].w; }
    LDS_WAIT(); asm volatile("" ::: "memory");
    const int c = lane & 7;
#pragma unroll
    for (int j = 0; j < 4; ++j) { const int n = (lane >> 3) + 8 * j; const LAS float* s = scr + (8 * c) * 33 + n;
        u32x4 o; o.x = cvt_pk(s[0 * 33], s[1 * 33]); o.y = cvt_pk(s[2 * 33], s[3 * 33]); o.z = cvt_pk(s[4 * 33], s[5 * 33]); o.w = cvt_pk(s[6 * 33], s[7 * 33]);
        int dn = n0 + n;
        if (MODE == 1) { const int up = dn >= DFF ? 1 : 0, jn = dn - up * DFF; dn = 256 * (jn >> 7) + 128 * up + (jn & 127); }
        *(u32x4*)(WT + (size_t)dn * K + k0 + 8 * c) = o; }
    LDS_WAIT(); asm volatile("" ::: "memory");
}

constexpr int IT_GU = (DM / 64) * (2 * DFF / 32);
constexpr int IT_D = (DFF / 64) * (DM / 32);
constexpr int IT_IN = (DM / 64) * ((DIN + 31) / 32);
constexpr int IT_OUT = (DM / 64) * (DM / 32);
constexpr int IT_LAYER = 2 * IT_GU + 2 * IT_D + IT_IN + IT_OUT;

DI void convert_layer_weights(KA a, int l, LAS unsigned char* lds, int gw, int NGW, int wave, int lane) {
    LAS float* scr = (LAS float*)(lds + wave * 8704);
    unsigned char* ws = a->ws;
    for (int it = gw; it < IT_LAYER; it += NGW) {
        int r = it;
        if (r < IT_GU) { transpose_item<1>(a->in[7] + (size_t)l * DM * 2 * DFF, a->in[6] + l * DM, DM, 2 * DFF, (bf16_t*)(ws + WS_WGU1), scr, r, lane); continue; } r -= IT_GU;
        if (r < IT_GU) { transpose_item<1>(a->in[23] + (size_t)l * DM * 2 * DFF, a->in[22] + l * DM, DM, 2 * DFF, (bf16_t*)(ws + WS_WGU2), scr, r, lane); continue; } r -= IT_GU;
        if (r < IT_D) { transpose_item<0>(a->in[8] + (size_t)l * DFF * DM, nullptr, DFF, DM, (bf16_t*)(ws + WS_WD1), scr, r, lane); continue; } r -= IT_D;
        if (r < IT_D) { transpose_item<0>(a->in[24] + (size_t)l * DFF * DM, nullptr, DFF, DM, (bf16_t*)(ws + WS_WD2), scr, r, lane); continue; } r -= IT_D;
        if (r < IT_IN) { transpose_item<0>(a->in[10] + (size_t)l * DM * DIN, a->in[9] + l * DM, DM, DIN, (bf16_t*)(ws + WS_WIN), scr, r, lane); continue; } r -= IT_IN;
        transpose_item<0>(a->in[21] + (size_t)l * DM * DM, nullptr, DM, DM, (bf16_t*)(ws + WS_WOUT), scr, r, lane);
    }
}

DI void prologue(KA a, LAS unsigned char* lds) {
    const int tid = opaque_tid(), lane = tid & 63, wave = tid >> 6;
    const int G = gridDim.x, gw = blockIdx.x * 8 + wave, NGW = G * 8;
    const int gt = blockIdx.x * 512 + tid, NGT = G * 512;
    unsigned char* ws = a->ws;
    { float* ss = (float*)(ws + WS_SS); for (int i = gt; i < 6 * MPAD; i += NGT) ss[MPAD + i] = 0.f; }
    { u32x4* p = (u32x4*)((bf16_t*)(ws + WS_WIN) + (size_t)2592 * DM); const int n = (UN - 2592) * DM / 8; for (int i = gt; i < n; i += NGT) p[i] = (u32x4){0u, 0u, 0u, 0u}; }
    { u32x4* p = (u32x4*)((bf16_t*)(ws + WS_Y) + (size_t)MTOK * DM); const int n = (MPAD - MTOK) * DM / 8; for (int i = gt; i < n; i += NGT) p[i] = (u32x4){0u, 0u, 0u, 0u}; }
    { bf16_t* wt = (bf16_t*)(ws + WS_WAT);
      for (int i = gt; i < 2 * 2 * 8 * 64 * 64; i += NGT) { const int k = i & 63, n = (i >> 6) & 63, blk = (i >> 12) & 7, g = (i >> 15) & 1, l = i >> 16;
          const float* src = g ? a->in[15] : a->in[13]; wt[i] = f2bf(src[((size_t)(l * 8 + blk) * 64 + k) * 64 + n]); } }
    convert_layer_weights(a, 0, lds, gw, NGW, wave, lane);
    { bf16_t* XB = (bf16_t*)(ws + WS_XB); float* ss0 = (float*)(ws + WS_SS);
      for (int rowb = gw; rowb < MPAD; rowb += 2 * NGW) {
          const float* src[2]; f32x4 v[2][4];
#pragma unroll
          for (int q = 0; q < 2; ++q) {
              const int row = rowb + q * NGW;
              src[q] = nullptr;
              if (row < MP) { const int b = row / LP, t = row - b * LP; src[q] = t < NMETA ? a->in[5] + (size_t)t * DM : a->in[0] + ((size_t)b * SEQ + (t - NMETA)) * DM; }
              else if (row < MTOK) src[q] = a->in[1] + (size_t)(row - MP) * DM;
#pragma unroll
              for (int j = 0; j < 4; ++j) v[q][j] = src[q] ? __builtin_nontemporal_load((const f32x4*)src[q] + lane + 64 * j) : (f32x4){0.f, 0.f, 0.f, 0.f};
          }
#pragma unroll
          for (int q = 0; q < 2; ++q) {
              const int row = rowb + q * NGW;
              if (row < MPAD) {
                  float s = 0.f;
                  u32x2* dst = (u32x2*)(XB + (size_t)row * DM) + lane;
#pragma unroll
                  for (int j = 0; j < 4; ++j) {
                      u32x2 o; o.x = cvt_pk(v[q][j].x, v[q][j].y); o.y = cvt_pk(v[q][j].z, v[q][j].w);
                      dst[64 * j] = o;
                      const float r0 = bf2f(o.x & 0xffffu), r1 = __uint_as_float(o.x & 0xffff0000u), r2 = bf2f(o.y & 0xffffu), r3 = __uint_as_float(o.y & 0xffff0000u);
                      s += r0 * r0 + r1 * r1 + r2 * r2 + r3 * r3;
                  }
                  s = wave_sum(s);
                  if (lane == 0) ss0[row] = s;
              }
          }
      } }
}

DI int crow(int reg, int h) { return (reg & 3) + 8 * (reg >> 2) + 4 * h; }
DI void mma_blk(f32x16& acc, const LAS bf16_t* A, const LAS bf16_t* B, int r, int h) {
#pragma unroll
    for (int ks = 0; ks < 4; ++ks) {
        const bf16x8 av = *(const LAS bf16x8*)(A + r * 72 + ks * 16 + 8 * h);
        const bf16x8 bv = *(const LAS bf16x8*)(B + r * 72 + ks * 16 + 8 * h);
        acc = __builtin_amdgcn_mfma_f32_32x32x16_bf16(av, bv, acc, 0, 0, 0);
    }
}
struct UnitInfo { int row0, nvalid, prompt, b, c, s; };
DI UnitInfo decode_unit(int unit) {
    UnitInfo u;
    if (unit < NUNIT_P) { u.prompt = 1; u.b = unit / NCH; u.c = unit - u.b * NCH; u.s = 0; const int tau0 = u.c == 0 ? 0 : NMETA + 64 * (u.c - 1); u.nvalid = u.c == 0 ? NMETA : 64; u.row0 = u.b * LP + tau0; }
    else { u.prompt = 0; u.s = unit - NUNIT_P; u.b = 0; u.c = 0; u.row0 = MP + LS * u.s; u.nvalid = LS; }
    return u;
}

template <bool FINAL>
DI void lru_unit(KA a, int l, int unit, LAS unsigned char* lds) {
    const UnitInfo u = decode_unit(unit);
    const int tid = opaque_tid(), lane = tid & 63, w = __builtin_amdgcn_readfirstlane(tid >> 6), r = lane & 31, h = lane >> 5;
    const bf16_t* U = (const bf16_t*)(a->ws + WS_HU);
    LAS bf16_t* xc = (LAS bf16_t*)lds + w * (64 * 72);
    LAS unsigned char* wsc = lds + 73728 + w * 8192;
    LAS bf16_t* xr = (LAS bf16_t*)wsc;
    const int row0 = u.row0, nvalid = u.nvalid;
    const bool lastc = u.prompt ? (u.c == NCH - 1) : true;
    float* out = a->out;
    const bf16_t* WaT = (const bf16_t*)(a->ws + WS_WAT) + ((size_t)(l * 2 + 0) * 8 + w) * 4096;
    const bf16_t* WxT = (const bf16_t*)(a->ws + WS_WAT) + ((size_t)(l * 2 + 1) * 8 + w) * 4096;
    {
        const int tr = lane >> 3, cg8 = (lane & 7) * 8;
        const bf16_t* src = U + (size_t)(row0 + tr) * UN + 64 * w + cg8;
        u32x4 v[8];
#pragma unroll
        for (int k = 0; k < 8; ++k) { v[k] = (u32x4){0u, 0u, 0u, 0u}; if (8 * k + tr < nvalid) v[k] = *(const u32x4*)(src + (size_t)(8 * k) * UN); }
#pragma unroll
        for (int k = 0; k < 8; ++k) *(LAS u32x4*)(xr + (8 * k + tr) * 64 + cg8) = v[k];
    }
    {
        const int ch = 64 * w + lane;
        const float* cw = a->in[11] + (size_t)l * 4 * DLRU;
        const float cw0 = cw[ch], cw1 = cw[DLRU + ch], cw2 = cw[2 * DLRU + ch], cw3 = cw[3 * DLRU + ch], cb = a->in[12][l * DLRU + ch];
        float xm3 = 0.f, xm2 = 0.f, xm1 = 0.f;
        if (u.prompt) { if (u.c > 0) { xm3 = bf2f(U[(size_t)(row0 - 3) * UN + ch]); xm2 = bf2f(U[(size_t)(row0 - 2) * UN + ch]); xm1 = bf2f(U[(size_t)(row0 - 1) * UN + ch]); } }
        else { const float* cs = a->in[3] + ((size_t)(l * NSB + u.s) * 3) * DLRU + ch; xm3 = cs[0]; xm2 = cs[DLRU]; xm1 = cs[2 * DLRU]; }
        float* cout = out + (u.prompt ? O_CP + (size_t)(l * NB + u.b) * 3 * DLRU : O_CS + (size_t)(l * NSB + u.s) * 3 * DLRU) + ch;
        LDS_WAIT(); asm volatile("" ::: "memory");
#pragma unroll 8
        for (int t = 0; t < 64; ++t) {
            const float xv = bf2f(xr[t * 64 + lane]);
            const float xcv = cb + cw0 * xm3 + cw1 * xm2 + cw2 * xm1 + cw3 * xv;
            xc[t * 72 + lane] = (t < nvalid) ? f2bf(xcv) : (bf16_t)0;
            xm3 = xm2; xm2 = xm1; xm1 = xv;
            if (FINAL && lastc && t >= nvalid - 3 && t < nvalid) cout[(size_t)(t - (nvalid - 3)) * DLRU] = xv;
        }
    }
    LDS_WAIT(); asm volatile("" ::: "memory");
    const int taur = 16 * ((r >> 2) & 1) + 4 * (r >> 3) + (r & 3);
#pragma unroll 1
    for (int nb = 0; nb < 2; ++nb) {
        f32x16 ar[2], ai[2];
#pragma unroll
        for (int i = 0; i < 16; ++i) { ar[0][i] = 0.f; ar[1][i] = 0.f; ai[0][i] = 0.f; ai[1][i] = 0.f; }
        u32x4 gv[4];
        if (FINAL) {
            const bf16_t* gp = U + (size_t)(row0 + (lane >> 2)) * UN + U_GL + 64 * w + 32 * nb + (lane & 3) * 8;
#pragma unroll
            for (int p = 0; p < 4; ++p) { gv[p] = (u32x4){0u, 0u, 0u, 0u}; if (16 * p + (lane >> 2) < nvalid) gv[p] = *(const u32x4*)(gp + (size_t)(16 * p) * UN); }
        }
#pragma unroll
        for (int ks = 0; ks < 4; ++ks) {
            const bf16x8 ba = *(const bf16x8*)(WaT + (nb * 32 + r) * 64 + ks * 16 + 8 * h);
            const bf16x8 bx = *(const bf16x8*)(WxT + (nb * 32 + r) * 64 + ks * 16 + 8 * h);
#pragma unroll
            for (int mb = 0; mb < 2; ++mb) {
                const bf16x8 av = *(const LAS bf16x8*)(xc + (mb * 32 + taur) * 72 + ks * 16 + 8 * h);
                ar[mb] = __builtin_amdgcn_mfma_f32_32x32x16_bf16(av, ba, ar[mb], 0, 0, 0);
                ai[mb] = __builtin_amdgcn_mfma_f32_32x32x16_bf16(av, bx, ai[mb], 0, 0, 0);
            }
        }
        const int cl = 32 * nb + r, chn = 64 * w + cl;
        const float ba_ = a->in[14][l * DLRU + chn], bx_ = a->in[16][l * DLRU + chn];
        const float c8 = -8.f * log1pf(__expf(-a->in[17][l * DLRU + chn]));
        float cin = 0.f;
        if (FINAL && !u.prompt) cin = a->in[2][(size_t)(l * NSB + u.s) * DLRU + chn];
#pragma unroll
        for (int mb = 0; mb < 2; ++mb) {
            float pp = 1.f, hh = 0.f;
#pragma unroll
            for (int i = 0; i < 16; ++i) {
                const int t = 32 * mb + 16 * h + i;
                const float rg = sigmoidf_(ar[mb][i] + ba_), ig = sigmoidf_(ai[mb][i] + bx_);
                const float la = c8 * rg;
                float av = __expf(la), mult = __builtin_amdgcn_sqrtf(fmaxf(1.f - av * av, 0.f));
                const float xcv = bf2f(xc[t * 72 + cl]);
                float bt = mult * ig * xcv;
                if (u.prompt && u.c == 0 && t == 0) { av = 0.f; bt = ig * xcv; }
                if (t >= nvalid) { av = 1.f; bt = 0.f; }
                hh = av * hh + bt; pp *= av;
                ar[mb][i] = pp; ai[mb][i] = hh;
            }
        }
        const float PA = ar[0][15], HA = ai[0][15], PB = ar[1][15], HB = ai[1][15];
        const float PAo = __shfl_xor(PA, 32), HAo = __shfl_xor(HA, 32), PBo = __shfl_xor(PB, 32), HBo = __shfl_xor(HB, 32);
        const float P0 = h ? PAo : PA, H0 = h ? HAo : HA, P1 = h ? PA : PAo, H1 = h ? HA : HAo;
        const float P2 = h ? PBo : PB, H2 = h ? HBo : HB, P3 = h ? PB : PBo, H3 = h ? HB : HBo;
        {
            if (u.prompt) {
                unsigned long long* ls = (unsigned long long*)(a->ws + WS_LSUM);
                unsigned* lf = (unsigned*)(a->ws + WS_LFLAG);
                const unsigned epoch = (unsigned)l + 1u;
                if (u.c < NCH - 1) {
                    const float Pt = P0 * P1 * P2 * P3, Ht = ((H0 * P1 + H1) * P2 + H2) * P3 + H3;
                    if (h == 0) __hip_atomic_store(ls + (size_t)unit * DLRU + chn, (unsigned long long)__float_as_uint(Pt) | ((unsigned long long)__float_as_uint(Ht) << 32), __ATOMIC_RELAXED, __HIP_MEMORY_SCOPE_AGENT);
                    asm volatile("s_waitcnt vmcnt(0)" ::: "memory");
                    if (lane == 0) __hip_atomic_store(lf + ((size_t)unit * 8 + w) * 2 + nb, epoch, __ATOMIC_RELAXED, __HIP_MEMORY_SCOPE_AGENT);
                }
                if (u.c > 0) {
                    {
                        const unsigned* fp = lf + ((size_t)(u.b * NCH + (lane < u.c ? lane : 0)) * 8 + w) * 2 + nb;
                        unsigned sp = 0;
                        for (;;) {
                            const bool ok = (lane >= u.c) || (__hip_atomic_load(fp, __ATOMIC_RELAXED, __HIP_MEMORY_SCOPE_AGENT) == epoch);
                            if (__all(ok)) break;
                            __builtin_amdgcn_s_sleep(2);
                            if (++sp > (1u << 22)) break;
                        }
                    }
                    const unsigned long long* lp = ls + (size_t)(u.b * NCH) * DLRU + chn;
                    for (int c0 = 0; c0 < u.c; c0 += 8) {
                        unsigned long long pv[8];
#pragma unroll
                        for (int k = 0; k < 8; ++k) { pv[k] = 0x3f800000ull; if (c0 + k < u.c) pv[k] = __hip_atomic_load(lp + (size_t)(c0 + k) * DLRU, __ATOMIC_RELAXED, __HIP_MEMORY_SCOPE_AGENT); }
#pragma unroll
                        for (int k = 0; k < 8; ++k) cin = __uint_as_float((unsigned)pv[k]) * cin + __uint_as_float((unsigned)(pv[k] >> 32));
                    }
                }
            }
            const float c1 = P0 * cin + H0, c2 = P1 * c1 + H1, c3 = P2 * c2 + H2;
            const float cA = h ? c1 : cin, cB = h ? c3 : c2;
            bf16_t* Y = (bf16_t*)(a->ws + WS_Y);
            float* hout = out + (u.prompt ? O_HP + (size_t)(l * NB + u.b) * DLRU : O_HS + (size_t)(l * NSB + u.s) * DLRU) + chn;
            LAS float* hb = (LAS float*)wsc;
#pragma unroll
            for (int mb = 0; mb < 2; ++mb)
#pragma unroll
                for (int i = 0; i < 16; ++i) hb[(32 * mb + 16 * h + i) * 32 + r] = ai[mb][i] + ar[mb][i] * (mb ? cB : cA);
            LDS_WAIT(); asm volatile("" ::: "memory");
            if (lastc && h == 0) *hout = hb[(nvalid - 1) * 32 + r];
            {
                const int tr = lane >> 2, c8o = (lane & 3) * 8;
                bf16_t* yp = Y + (size_t)(row0 + tr) * DM + 64 * w + 32 * nb + c8o;
#pragma unroll
                for (int p = 0; p < 4; ++p) {
                    if (16 * p + tr < nvalid) {
                        const f32x4 h0 = *(const LAS f32x4*)(hb + (16 * p + tr) * 32 + c8o), h1 = *(const LAS f32x4*)(hb + (16 * p + tr) * 32 + c8o + 4);
                        float g[8]; unpack8(gv[p], g);
                        u32x4 o; o.x = cvt_pk(h0.x * gelu_tanh(g[0]), h0.y * gelu_tanh(g[1])); o.y = cvt_pk(h0.z * gelu_tanh(g[2]), h0.w * gelu_tanh(g[3]));
                        o.z = cvt_pk(h1.x * gelu_tanh(g[4]), h1.y * gelu_tanh(g[5])); o.w = cvt_pk(h1.z * gelu_tanh(g[6]), h1.w * gelu_tanh(g[7]));
                        *(u32x4*)(yp + (size_t)(16 * p) * DM) = o;
                    }
                }
            }
            LDS_WAIT(); asm volatile("" ::: "memory");
        }
    }
}

constexpr int GL_GSUM = 0, GL_DS = 2048, GL_QS = 4096, GL_KS = 13312, GL_VT = 22528, GL_ST = 40960, GL_ATT = 59392, GL_OB = 68608;
DI void mma_blk_swz(f32x16& acc, const LAS bf16_t* A, const LAS bf16_t* Bsw, int r, int h, int rowB0) {
    const int swz = ((rowB0 + r) >> 4) & 7;
#pragma unroll
    for (int ks = 0; ks < 4; ++ks) {
        const bf16x8 av = *(const LAS bf16x8*)(A + r * 72 + ks * 16 + 8 * h);
        const bf16x8 bv = *(const LAS bf16x8*)(Bsw + (rowB0 + r) * 72 + (((2 * ks + h) ^ swz) << 3));
        acc = __builtin_amdgcn_mfma_f32_32x32x16_bf16(av, bv, acc, 0, 0, 0);
    }
}
constexpr int GL_HEAD = 68608;
template <bool FINAL>
DI void gla_unit(KA a, int l, int item, LAS unsigned char* lds) {
    const int unit = item >> 1, hp = item & 1;
    const UnitInfo u = decode_unit(unit);
    const int tid = opaque_tid(), lane = tid & 63, w = __builtin_amdgcn_readfirstlane(tid >> 6), r = lane & 31, h = lane >> 5;
    const bf16_t* U = (const bf16_t*)(a->ws + WS_HU);
    const int row0 = u.row0, nvalid = u.nvalid;
    const int dk = lane, tg = w;
    const int vj = tid >> 3, vdvc = (tid & 7) * 16;
    unsigned kraw[2][8], qraw[2][8];
    u32x4 v0[2], v1[2], g0[2], g1[2];
    f32x4 sv[2][4];
    const float* S0[2];
#pragma unroll
    for (int hh = 0; hh < 2; ++hh) {
        const int hd = 2 * hp + hh;
#pragma unroll
        for (int jj = 0; jj < 8; ++jj) {
            const int t = 8 * tg + jj; kraw[hh][jj] = 0u; qraw[hh][jj] = 0u;
            if (t < nvalid) { kraw[hh][jj] = U[(size_t)(row0 + t) * UN + U_K + hd * 64 + dk]; if (FINAL) qraw[hh][jj] = U[(size_t)(row0 + t) * UN + U_Q + hd * 64 + dk]; }
        }
        v0[hh] = (u32x4){0u, 0u, 0u, 0u}; v1[hh] = v0[hh]; g0[hh] = v0[hh]; g1[hh] = v0[hh];
        if (vj < nvalid) {
            const u32x4* vp = (const u32x4*)(U + (size_t)(row0 + vj) * UN + U_V + hd * 128 + vdvc); v0[hh] = vp[0]; v1[hh] = vp[1];
            if (FINAL) { const u32x4* gp = (const u32x4*)(U + (size_t)(row0 + vj) * UN + U_GO + hd * 128 + vdvc); g0[hh] = gp[0]; g1[hh] = gp[1]; }
        }
        S0[hh] = nullptr;
        if (!u.prompt) S0[hh] = a->in[4] + (size_t)((l * NSB + u.s) * 4 + hd) * 8192;
        if (FINAL) {
            const bf16_t* Sb = (u.prompt && u.c > 0) ? (const bf16_t*)(a->ws + WS_SB) + (size_t)(unit * 4 + hd) * 8192 : nullptr;
#pragma unroll
            for (int it = 0; it < 4; ++it) {
                const int idx = it * 512 + tid; sv[hh][it] = (f32x4){0.f, 0.f, 0.f, 0.f};
                if (S0[hh]) sv[hh][it] = *(const f32x4*)(S0[hh] + (idx >> 5) * 128 + (idx & 31) * 4);
                else if (Sb) { const u32x2 v = *(const u32x2*)(Sb + (idx >> 5) * 128 + (idx & 31) * 4); sv[hh][it] = (f32x4){bf2f(v.x & 0xffffu), __uint_as_float(v.x & 0xffff0000u), bf2f(v.y & 0xffffu), __uint_as_float(v.y & 0xffff0000u)}; }
            }
        }
    }
    f32x4 gnv[4];
    if (FINAL) {
#pragma unroll
        for (int q = 0; q < 4; ++q) gnv[q] = *(const f32x4*)(a->in[20] + l * DV + vdvc + 4 * q);
    }
    float s0v[2][16];
    if (!FINAL && !u.prompt) {
#pragma unroll
        for (int hh = 0; hh < 2; ++hh)
#pragma unroll
            for (int i = 0; i < 16; ++i) s0v[hh][i] = __builtin_nontemporal_load(S0[hh] + (32 * (w >> 2) + crow(i, h)) * 128 + 32 * (w & 3) + r);
    }
    float bl[2][8];
    {
        float wg[2][16], bg[2];
#pragma unroll
        for (int hh = 0; hh < 2; ++hh) {
            const float* wg2 = a->in[18] + (size_t)l * 16 * 256 + (2 * hp + hh) * 64 + dk;
#pragma unroll
            for (int e = 0; e < 16; ++e) wg[hh][e] = wg2[e * 256];
            bg[hh] = a->in[19][l * 256 + (2 * hp + hh) * 64 + dk];
        }
        float run0 = 0.f, run1 = 0.f;
#pragma unroll
        for (int jj = 0; jj < 8; ++jj) {
            const int t = 8 * tg + jj;
            float ga = 0.f, gb = 0.f;
            if (t < nvalid) {
                const u32x4* lp = (const u32x4*)(U + (size_t)(row0 + t) * UN + U_LR);
                float lr[16]; unpack8(lp[0], lr); unpack8(lp[1], lr + 8);
                float za = bg[0], zb = bg[1];
#pragma unroll
                for (int e = 0; e < 16; ++e) { za += wg[0][e] * lr[e]; zb += wg[1][e] * lr[e]; }
                ga = (fminf(za, 0.f) - __logf(1.f + __expf(-fabsf(za)))) * (1.f / 16.f);
                gb = (fminf(zb, 0.f) - __logf(1.f + __expf(-fabsf(zb)))) * (1.f / 16.f);
            }
            run0 += ga; run1 += gb; bl[0][jj] = run0; bl[1][jj] = run1;
        }
        ((LAS float*)(lds + GL_GSUM))[tg * 64 + dk] = run0;
        ((LAS float*)(lds + GL_HEAD + GL_GSUM))[tg * 64 + dk] = run1;
    }
#pragma unroll
    for (int hh = 0; hh < 2; ++hh) {
        LAS bf16_t* vT = (LAS bf16_t*)(lds + hh * GL_HEAD + GL_VT); LAS bf16_t* sT = (LAS bf16_t*)(lds + hh * GL_HEAD + GL_ST);
        {
            const unsigned vv[8] = {v0[hh].x, v0[hh].y, v0[hh].z, v0[hh].w, v1[hh].x, v1[hh].y, v1[hh].z, v1[hh].w};
            const int col = ((((vj >> 3) ^ ((vdvc >> 4) & 7)) << 3) | (vj & 7));
#pragma unroll
            for (int e = 0; e < 8; ++e) { vT[(vdvc + 2 * e) * 72 + col] = (bf16_t)(vv[e] & 0xffffu); vT[(vdvc + 2 * e + 1) * 72 + col] = (bf16_t)(vv[e] >> 16); }
        }
        if (FINAL) {
#pragma unroll
            for (int it = 0; it < 4; ++it) {
                const int idx = it * 512 + tid, dkk = idx >> 5, dv4 = (idx & 31) * 4;
                const int col = ((((dkk >> 3) ^ ((dv4 >> 4) & 7)) << 3) | (dkk & 7));
                sT[(dv4 + 0) * 72 + col] = f2bf(sv[hh][it].x); sT[(dv4 + 1) * 72 + col] = f2bf(sv[hh][it].y); sT[(dv4 + 2) * 72 + col] = f2bf(sv[hh][it].z); sT[(dv4 + 3) * 72 + col] = f2bf(sv[hh][it].w);
            }
        }
    }
    LBAR();
#pragma unroll
    for (int hh = 0; hh < 2; ++hh) {
        LAS float* gsum = (LAS float*)(lds + hh * GL_HEAD + GL_GSUM); LAS float* dS = (LAS float*)(lds + hh * GL_HEAD + GL_DS);
        LAS bf16_t* qs = (LAS bf16_t*)(lds + hh * GL_HEAD + GL_QS); LAS bf16_t* ks = (LAS bf16_t*)(lds + hh * GL_HEAD + GL_KS);
        float prefix = 0.f, blast = 0.f;
#pragma unroll
        for (int g2 = 0; g2 < 8; ++g2) { const float v = gsum[g2 * 64 + dk]; blast += v; if (g2 < tg) prefix += v; }
#pragma unroll
        for (int jj = 0; jj < 8; ++jj) {
            const int t = 8 * tg + jj;
            const float bj = prefix + bl[hh][jj];
            const float kv = bf2f(kraw[hh][jj]);
            if (FINAL) { qs[t * 72 + dk] = f2bf(bf2f(qraw[hh][jj]) * 0.125f * __expf(bj)); ks[t * 72 + dk] = f2bf(kv * __expf(-bj)); }
            else ks[dk * 72 + t] = f2bf(kv * __expf(blast - bj));
        }
        if (!FINAL && tg == 0) { const float d = __expf(blast); dS[dk] = d; if (u.prompt) ((float*)(a->ws + WS_DBUF))[(size_t)(unit * 4 + 2 * hp + hh) * 64 + dk] = d; }
    }
    LBAR();
    if (!FINAL) {
#pragma unroll
        for (int hh = 0; hh < 2; ++hh) {
            const int hd = 2 * hp + hh;
            LAS float* dS = (LAS float*)(lds + hh * GL_HEAD + GL_DS);
            LAS bf16_t* ks = (LAS bf16_t*)(lds + hh * GL_HEAD + GL_KS); LAS bf16_t* vT = (LAS bf16_t*)(lds + hh * GL_HEAD + GL_VT);
            const int mb = w >> 2, nb = w & 3;
            f32x16 acc;
#pragma unroll
            for (int i = 0; i < 16; ++i) acc[i] = 0.f;
            mma_blk_swz(acc, ks + mb * 32 * 72, vT, r, h, nb * 32);
            const int dvc = 32 * nb + r;
            if (u.prompt) {
                bf16_t* dst = (bf16_t*)(a->ws + WS_SB) + (size_t)(unit * 4 + hd) * 8192;
#pragma unroll
                for (int i = 0; i < 16; ++i) dst[(32 * mb + crow(i, h)) * 128 + dvc] = f2bf(acc[i]);
            } else {
                float* dst = a->out + O_SS + (size_t)((l * NSB + u.s) * 4 + hd) * 8192;
#pragma unroll
                for (int i = 0; i < 16; ++i) { const int dkr = 32 * mb + crow(i, h); dst[dkr * 128 + dvc] = dS[dkr] * s0v[hh][i] + acc[i]; }
            }
        }
    } else {
        {
            const int hh = w >> 2, ww = w & 3, mi = ww >> 1, nj = ww & 1;
            LAS bf16_t* qs = (LAS bf16_t*)(lds + hh * GL_HEAD + GL_QS); LAS bf16_t* ks = (LAS bf16_t*)(lds + hh * GL_HEAD + GL_KS); LAS bf16_t* att = (LAS bf16_t*)(lds + hh * GL_HEAD + GL_ATT);
            f32x16 acc;
#pragma unroll
            for (int i = 0; i < 16; ++i) acc[i] = 0.f;
            if (!(mi == 0 && nj == 1)) mma_blk(acc, qs + mi * 32 * 72, ks + nj * 32 * 72, r, h);
#pragma unroll
            for (int i = 0; i < 16; ++i) { const int irow = 32 * mi + crow(i, h), jcol = 32 * nj + r; att[irow * 72 + jcol] = f2bf(irow >= jcol ? acc[i] : 0.f); }
        }
        LBAR();
        f32x16 oacc[2];
        const int mi = w >> 2, nv = w & 3;
#pragma unroll
        for (int hh = 0; hh < 2; ++hh) {
            LAS bf16_t* qs = (LAS bf16_t*)(lds + hh * GL_HEAD + GL_QS); LAS bf16_t* vT = (LAS bf16_t*)(lds + hh * GL_HEAD + GL_VT);
            LAS bf16_t* sT = (LAS bf16_t*)(lds + hh * GL_HEAD + GL_ST); LAS bf16_t* att = (LAS bf16_t*)(lds + hh * GL_HEAD + GL_ATT);
#pragma unroll
            for (int i = 0; i < 16; ++i) oacc[hh][i] = 0.f;
            mma_blk_swz(oacc[hh], att + mi * 32 * 72, vT, r, h, nv * 32);
            mma_blk_swz(oacc[hh], qs + mi * 32 * 72, sT, r, h, nv * 32);
        }
        LBAR();
#pragma unroll
        for (int hh = 0; hh < 2; ++hh) {
            LAS float* ob = (LAS float*)(lds + hh * GL_HEAD + GL_VT);
#pragma unroll
            for (int i = 0; i < 16; ++i) ob[(32 * mi + crow(i, h)) * 132 + 32 * nv + r] = oacc[hh][i];
        }
        LBAR();
#pragma unroll
        for (int hh = 0; hh < 2; ++hh) {
            const int hd = 2 * hp + hh;
            const LAS float* ob = (const LAS float*)(lds + hh * GL_HEAD + GL_VT);
            const int i = vj, dvc = vdvc;
            float o[16];
#pragma unroll
            for (int q = 0; q < 4; ++q) { const f32x4 v = *(const LAS f32x4*)(ob + i * 132 + dvc + 4 * q); o[4 * q] = v.x; o[4 * q + 1] = v.y; o[4 * q + 2] = v.z; o[4 * q + 3] = v.w; }
            float s = 0.f;
#pragma unroll
            for (int e = 0; e < 16; ++e) s += o[e] * o[e];
            s += __shfl_xor(s, 1); s += __shfl_xor(s, 2); s += __shfl_xor(s, 4);
            const float rs = rsqrtf(s * (1.f / DV) + EPS);
            if (i < nvalid) {
                float go[16]; unpack8(g0[hh], go); unpack8(g1[hh], go + 8);
                float y[16];
#pragma unroll
                for (int e = 0; e < 16; ++e) y[e] = o[e] * rs * gnv[e >> 2][e & 3] * siluf_(go[e]);
                u32x4 w0, w1;
                w0.x = cvt_pk(y[0], y[1]); w0.y = cvt_pk(y[2], y[3]); w0.z = cvt_pk(y[4], y[5]); w0.w = cvt_pk(y[6], y[7]);
                w1.x = cvt_pk(y[8], y[9]); w1.y = cvt_pk(y[10], y[11]); w1.z = cvt_pk(y[12], y[13]); w1.w = cvt_pk(y[14], y[15]);
                u32x4* yp = (u32x4*)((bf16_t*)(a->ws + WS_Y) + (size_t)(row0 + i) * DM + DLRU + hd * 128 + dvc);
                yp[0] = w0; yp[1] = w1;
            }
        }
    }
    LBAR();
}

DI void state_scan(KA a, int l) {
    const int gt = blockIdx.x * 512 + opaque_tid(), NGT = gridDim.x * 512;
    float* SB = (float*)(a->ws + WS_SB); const float* db = (const float*)(a->ws + WS_DBUF);
    bf16_t* SBh = (bf16_t*)SB;
    for (int q = gt; q < NB * NH * 1024; q += NGT) {
        const int e = (q & 1023) * 8, bh = q >> 10, b = bh >> 2, hd = bh & 3, dkk = e >> 7;
        float S[8];
#pragma unroll
        for (int k = 0; k < 8; ++k) S[k] = 0.f;
#pragma unroll 11
        for (int c = 0; c < NCH; ++c) {
            const int uu = b * NCH + c;
            u32x4* p = (u32x4*)(SBh + (size_t)(uu * 4 + hd) * 8192 + e);
            float uv[8]; unpack8(*p, uv);
            const float d = db[(size_t)(uu * 4 + hd) * 64 + dkk];
            u32x4 w; w.x = cvt_pk(S[0], S[1]); w.y = cvt_pk(S[2], S[3]); w.z = cvt_pk(S[4], S[5]); w.w = cvt_pk(S[6], S[7]);
            *p = w;
#pragma unroll
            for (int k = 0; k < 8; ++k) S[k] = d * S[k] + uv[k];
        }
        float* o = a->out + O_SP + (size_t)((l * NB + b) * 4 + hd) * 8192 + e;
        *(f32x4*)o = (f32x4){S[0], S[1], S[2], S[3]}; *(f32x4*)(o + 4) = (f32x4){S[4], S[5], S[6], S[7]};
    }
    { u32x4* p = (u32x4*)((bf16_t*)(a->ws + WS_Y) + (size_t)MTOK * DM); const int n = (MPAD - MTOK) * DM / 8; for (int i = gt; i < n; i += NGT) p[i] = (u32x4){0u, 0u, 0u, 0u}; }
}

#define XB_TMO      128
#define XB_XCNT(j)  (256  + 64 * (j))
#define XB_XSUB(j)  (1280 + 64 * (j))
#define XB_XGEN(j)  (2304 + 64 * (j))
#define XB_TOP      3328
#define XB_TOPGEN   3392
#define XCD_BAR_WORDS 3456
#define XB_SPIN_CAP (1u << 20)
DI unsigned xb_ld(unsigned* p)              { return __hip_atomic_load(p, __ATOMIC_RELAXED, __HIP_MEMORY_SCOPE_AGENT); }
DI unsigned xb_add(unsigned* p, unsigned v) { return __hip_atomic_fetch_add(p, v, __ATOMIC_RELAXED, __HIP_MEMORY_SCOPE_AGENT); }
DI unsigned xb_xcc_id() { return (unsigned)__builtin_amdgcn_s_getreg((3 << 11) | 20) & 0xFu; }
#define XB_SPIN(cond, bar) do { unsigned _sp = 0; while (cond) { \
    if ((++_sp & 255u) == 0u) { if (xb_ld(&(bar)[XB_TMO])) break; if (_sp > XB_SPIN_CAP) { atomicAdd(&(bar)[XB_TMO], 1u); break; } } } } while (0)
struct XcdBarrier { unsigned* bar; unsigned x; volatile LAS unsigned* st; };
DI XcdBarrier xcd_barrier_post(unsigned* bar, volatile LAS unsigned* st) {
    XcdBarrier b; b.bar = bar; b.x = xb_xcc_id(); b.st = st;
    if (threadIdx.x == 0) (void)xb_add(&bar[XB_XCNT(b.x)], 1u);
    return b;
}
DI void xcd_barrier_complete(unsigned* bar, unsigned x, unsigned& nloc, unsigned& nx) {
    const unsigned G = gridDim.x * gridDim.y * gridDim.z;
    unsigned sum, cnt, mine, sp = 0u;
    for (;;) {
        sum = 0u; cnt = 0u; mine = 0u;
#pragma unroll
        for (unsigned j = 0; j < 16; ++j) { const unsigned c = xb_ld(&bar[XB_XCNT(j)]); sum += c; cnt += (c > 0u) ? 1u : 0u; mine = (j == x) ? c : mine; }
        if (sum == G) break;
        __builtin_amdgcn_s_sleep(1);
        if ((++sp & 255u) == 0u) { if (xb_ld(&bar[XB_TMO])) break; if (sp > XB_SPIN_CAP) { atomicAdd(&bar[XB_TMO], 1u); break; } }
    }
    nloc = mine > 0u ? mine : 1u; nx = cnt > 0u ? cnt : 1u;
}
DI void xcd_barrier(const XcdBarrier& b) {
    asm volatile("s_waitcnt vmcnt(0)" ::: "memory");
    __syncthreads();
    if (threadIdx.x == 0) {
        unsigned* bar = b.bar;
        __builtin_amdgcn_s_waitcnt(0);
        unsigned nloc = b.st[0], nx = b.st[1];
        if (nloc == 0u) { xcd_barrier_complete(bar, b.x, nloc, nx); b.st[0] = nloc; b.st[1] = nx; }
        const unsigned old = xb_add(&bar[XB_XSUB(b.x)], 1u);
        const unsigned gen = old / nloc;
        if (old + 1u == (gen + 1u) * nloc) {
            __builtin_amdgcn_fence(__ATOMIC_RELEASE, "agent");
            asm volatile("s_waitcnt vmcnt(0)" ::: "memory");
            const unsigned og = xb_add(&bar[XB_TOP], 1u);
            const unsigned tg = og / nx;
            if (og + 1u == (tg + 1u) * nx) xb_add(&bar[XB_TOPGEN], 1u);
            else XB_SPIN(xb_ld(&bar[XB_TOPGEN]) == tg, bar);
            __builtin_amdgcn_fence(__ATOMIC_ACQUIRE, "agent");
            xb_add(&bar[XB_XGEN(b.x)], 1u);
            asm volatile("s_waitcnt vmcnt(0)" ::: "memory");
        } else {
            XB_SPIN(xb_ld(&bar[XB_XGEN(b.x)]) == gen, bar);
            __builtin_amdgcn_fence(__ATOMIC_ACQUIRE, "agent");
            asm volatile("s_waitcnt vmcnt(0)" ::: "memory");
        }
    }
    __syncthreads();
}

#ifndef REP_M1
#define REP_M1 1
#endif
#ifndef REP_M3L
#define REP_M3L 1
#endif
#ifndef REP_M3G
#define REP_M3G 1
#endif
#ifndef REP_SYNC
#define REP_SYNC 1
#endif
#ifndef REP_G
#define REP_G 1
#endif
template <class Epi, class... EA>
DI void run_gemm(LAS unsigned char* lds, size_t offA, size_t offB, int N, int K, const EA&... ea) {
    const KA a = get_ka(); unsigned char* ws = a->ws;
    pg8::Gemm g{(const bf16_t*)(ws + offA), (const bf16_t*)(ws + offB), MPAD, N, K}; pg8::StaticOrder S; S.init(MPAD, N, K, gridDim.x, blockIdx.x);
    const Epi E = Epi::make(ws, ea...);
    pg8::gemm_phase<Epi, pg8::StaticOrder, true, true>(lds, g, S, E);
}
DI void run_gemm_res(LAS unsigned char* lds, size_t offA, size_t offB, int K, int ssi, float sc, size_t part_off, unsigned epoch) {
    const KA a = get_ka(); unsigned char* ws = a->ws;
    pg8::Gemm g{(const bf16_t*)(ws + offA), (const bf16_t*)(ws + offB), MPAD, DM, K};
    const pg8::EpiRes E = pg8::EpiRes::make(ws, ssi, sc, part_off, epoch);
    const int G = gridDim.x, bx = blockIdx.x;
    if ((G & 7) == 0 && (long)276 * (K / 128) >= (long)G * (K / 128)) {
        pg8::SKOrder S; S.init(K, G, (bx & 7) * (G >> 3) + (bx >> 3));
        pg8::gemm_phase<pg8::EpiRes, pg8::SKOrder, true, true>(lds, g, S, E);
    } else {
        pg8::StaticOrder S; S.init(MPAD, DM, K, G, bx);
        pg8::gemm_phase<pg8::EpiRes, pg8::StaticOrder, true, true>(lds, g, S, E);
    }
}

__global__ void __launch_bounds__(512, 2) hymba_fwd(Args a_unused) {
    extern __shared__ __attribute__((aligned(16))) unsigned char lds_raw[];
    LAS unsigned char* lds = (LAS unsigned char*)lds_raw;
    cg::grid_group grid = cg::this_grid();
    if (gridDim.x == 0x7fffffffu) grid.sync();
    volatile LAS unsigned* bst = (volatile LAS unsigned*)(lds + 147200);
    if (threadIdx.x < 2) bst[threadIdx.x] = 0u;
    __syncthreads();
    (void)xcd_barrier_post((unsigned*)(get_ka()->ws), bst);
#define GSYNC() do { XcdBarrier _b; _b.bar = (unsigned*)(get_ka()->ws); _b.x = xb_xcc_id(); _b.st = (volatile LAS unsigned*)(lds + 147200); xcd_barrier(_b); } while (0)

#ifndef REP_PRO
#define REP_PRO 1
#endif
    for (int rep = 0; rep < REP_PRO; ++rep) { prologue(get_ka(), lds); __syncthreads(); }
    GSYNC();
#pragma unroll 1
    for (int l = 0; l < 2; ++l) {
        if (l == 1) {
            const int tid = opaque_tid(), wave = tid >> 6, lane = tid & 63;
            for (int rep = 0; rep < REP_PRO; ++rep) { convert_layer_weights(get_ka(), 1, lds, blockIdx.x * 8 + wave, gridDim.x * 8, wave, lane); __syncthreads(); }
            GSYNC();
        }
        for (int rep = 0; rep < REP_G; ++rep)
        run_gemm<pg8::EpiSwiGLU>(lds, WS_XB, WS_WGU1, 2 * DFF, DM, 3 * l + 0);
        for (int rep = 0; rep < REP_SYNC; ++rep)
        GSYNC();
        run_gemm_res(lds, WS_HU, WS_WD1, DFF, 3 * l + 1, 0.5f, WS_Y, 3 * l + 1);
        GSYNC();
        run_gemm<pg8::EpiRowScale>(lds, WS_XB, WS_WIN, UN, DM, 3 * l + 1);
        GSYNC();
        for (int rep = 0; rep < REP_M1; ++rep)
        for (int it = blockIdx.x; it < 2 * NUNIT; it += gridDim.x) gla_unit<false>(get_ka(), l, it, lds);
        GSYNC();
        state_scan(get_ka(), l);
        GSYNC();
        for (int it = blockIdx.x; it < NUNIT + 2 * NUNIT; it += gridDim.x) {
            if (it < NUNIT) { lru_unit<true>(get_ka(), l, it, lds); LBAR(); }
            else { for (int rep = 0; rep < REP_M3G; ++rep) gla_unit<true>(get_ka(), l, it - NUNIT, lds); }
        }
        GSYNC();
        run_gemm_res(lds, WS_Y, WS_WOUT, DM, 3 * l + 2, 1.0f, WS_HU, 3 * l + 2);
        GSYNC();
        run_gemm<pg8::EpiSwiGLU>(lds, WS_XB, WS_WGU2, 2 * DFF, DM, 3 * l + 2);
        GSYNC();
        run_gemm_res(lds, WS_HU, WS_WD2, DFF, 3 * l + 3, 0.5f, WS_Y, 3 * l + 3);
        GSYNC();
    }
    {
        const KA a = get_ka();
        const int tid = opaque_tid(), wave = tid >> 6, lane = tid & 63, G = gridDim.x;
        const float* nf = a->in[25];
        const float* ssf = (const float*)(a->ws + WS_SS) + 6 * MPAD;
        const bf16_t* XB = (const bf16_t*)(a->ws + WS_XB);
        float* out = a->out;
        f32x4 nfv[2][2];
#pragma unroll
        for (int j = 0; j < 2; ++j) { nfv[j][0] = *(const f32x4*)(nf + (lane + 64 * j) * 8); nfv[j][1] = *(const f32x4*)(nf + (lane + 64 * j) * 8 + 4); }
        for (int rowb = blockIdx.x * 8 + wave; rowb < MTOK; rowb += 2 * G * 8) {
            float* dst[2]; u32x4 xr[2][2]; float rs[2];
#pragma unroll
            for (int q = 0; q < 2; ++q) {
                const int row = rowb + q * G * 8;
                dst[q] = nullptr;
                if (row < MP) { const int b = row / LP, t = row - b * LP; if (t >= NMETA) dst[q] = out + O_YP + ((size_t)b * SEQ + (t - NMETA)) * DM; }
                else if (row < MTOK) dst[q] = out + O_YS + (size_t)(row - MP) * DM;
                if (dst[q]) { rs[q] = rsqrtf(ssf[row] * (1.f / DM) + EPS); const u32x4* src = (const u32x4*)(XB + (size_t)row * DM); xr[q][0] = src[lane]; xr[q][1] = src[lane + 64]; }
            }
#pragma unroll
            for (int q = 0; q < 2; ++q) {
                if (dst[q]) {
#pragma unroll
                    for (int j = 0; j < 2; ++j) {
                        const int c8 = (lane + 64 * j) * 8;
                        float xv[8]; unpack8(xr[q][j], xv);
                        const f32x4 n0 = nfv[j][0], n1 = nfv[j][1];
                        const float r = rs[q];
                        __builtin_nontemporal_store((f32x4){xv[0] * r * n0.x, xv[1] * r * n0.y, xv[2] * r * n0.z, xv[3] * r * n0.w}, (f32x4*)(dst[q] + c8));
                        __builtin_nontemporal_store((f32x4){xv[4] * r * n1.x, xv[5] * r * n1.y, xv[6] * r * n1.z, xv[7] * r * n1.w}, (f32x4*)(dst[q] + c8 + 4));
                    }
                }
            }
        }
    }
}

extern "C" void kernel_launch(void* const* d_in, const int* in_sizes, int n_in, void* d_out, int out_size, void* d_ws, size_t ws_size, hipStream_t stream) {
    static int grid = 0;
    if (grid == 0) {
        if (n_in != 26 || ws_size < WS_END) { fprintf(stderr, "kernel_launch: unexpected n_in %d / ws_size %zu\n", n_in, ws_size); grid = -1; return; }
        int dev = 0, cus = 0, per_cu = 0;
        hipGetDevice(&dev);
        hipDeviceGetAttribute(&cus, hipDeviceAttributeMultiprocessorCount, dev);
        if (hipFuncSetAttribute((const void*)hymba_fwd, hipFuncAttributeMaxDynamicSharedMemorySize, LDS_BYTES) != hipSuccess) { fprintf(stderr, "kernel_launch: hipFuncSetAttribute failed\n"); grid = -1; return; }
        if (hipOccupancyMaxActiveBlocksPerMultiprocessor(&per_cu, (const void*)hymba_fwd, 512, LDS_BYTES) != hipSuccess || per_cu < 1) { fprintf(stderr, "kernel_launch: occupancy query says %d\n", per_cu); per_cu = 1; }
        (void)hipGetLastError();
        grid = cus;
    }
    if (grid < 0) return;
    if (hipMemsetAsync(d_ws, 0, 65536, stream) != hipSuccess) { fprintf(stderr, "kernel_launch: memset failed\n"); return; }
    Args a{};
    for (int i = 0; i < 26; ++i) a.in[i] = (const float*)d_in[i];
    a.out = (float*)d_out; a.ws = (unsigned char*)d_ws;
    void* args[] = {&a};
    hipError_t e = hipLaunchCooperativeKernel((const void*)hymba_fwd, dim3(grid), dim3(512), args, LDS_BYTES, stream);
    if (e != hipSuccess) fprintf(stderr, "cooperative launch failed: %s (grid %d)\n", hipGetErrorString(e), grid);
}
```

```cpp
#include <hip/hip_runtime.h>
#include <hip/hip_cooperative_groups.h>
#include <cstdio>
#include <cstdint>
namespace cg = cooperative_groups;

#define DI __device__ __forceinline__
#define LAS __attribute__((address_space(3)))
typedef unsigned short bf16_t;
typedef short bf16x8 __attribute__((ext_vector_type(8)));
typedef float f32x4 __attribute__((ext_vector_type(4)));
typedef float f32x16 __attribute__((ext_vector_type(16)));
typedef unsigned u32x4 __attribute__((ext_vector_type(4)));
typedef unsigned u32x2 __attribute__((ext_vector_type(2)));

constexpr int DM = 1024, NB = 8, SEQ = 2048, NMETA = 16, LP = SEQ + NMETA, NSB = 128, LS = 8;
constexpr int MP = NB * LP;
constexpr int MS = NSB * LS;
constexpr int MTOK = MP + MS;
constexpr int MPAD = 17664;
constexpr int DFF = 2816, DLRU = 512, NH = 4, DK = 64, DV = 128, DIN = 2576, UN = 2816;
constexpr int NCH = 33, NUNIT_P = NB * NCH, NUNIT = NUNIT_P + NSB;
constexpr int U_XL = 0, U_GL = 512, U_Q = 1024, U_K = 1280, U_V = 1536, U_GO = 2048, U_LR = 2560;
constexpr float EPS = 1e-6f;
constexpr size_t O_YP = 0, O_YS = 16777216, O_HP = 17825792, O_CP = 17833984, O_SP = 17858560, O_HS = 18382848, O_CS = 18513920, O_SS = 18907136;
constexpr size_t MiB = 1u << 20;
constexpr size_t WS_SS = 1 * MiB;
constexpr size_t WS_WAT = 1 * MiB + 512 * 1024;
constexpr size_t WS_FLAGS = 16384;
constexpr size_t WS_LFLAG = 32768;
constexpr size_t WS_LSUM = 2 * MiB;
constexpr size_t WS_DBUF = 3 * MiB + 512 * 1024;
constexpr size_t WS_WGU1 = 4 * MiB, WS_WD1 = 15 * MiB, WS_WIN = 20 * MiB + 512 * 1024, WS_WOUT = 26 * MiB, WS_WGU2 = 28 * MiB, WS_WD2 = 39 * MiB;
constexpr size_t WS_XB = 45 * MiB, WS_HU = 80 * MiB, WS_Y = 175 * MiB, WS_SB = 210 * MiB, WS_END = 243 * MiB;
constexpr int LDS_BYTES = 147456;

DI float bf2f(unsigned v) { return __uint_as_float(v << 16); }
DI unsigned cvt_pk(float lo, float hi) { unsigned r; asm("v_cvt_pk_bf16_f32 %0, %1, %2" : "=v"(r) : "v"(lo), "v"(hi)); return r; }
DI bf16_t f2bf(float f) { return (bf16_t)(cvt_pk(f, 0.f) & 0xffffu); }
DI float rcpf(float x) { return __builtin_amdgcn_rcpf(x); }
DI float sigmoidf_(float x) { return rcpf(1.f + __expf(-x)); }
DI float siluf_(float x) { return x * sigmoidf_(x); }
DI float gelu_tanh(float x) { const float u = 0.7978845608028654f * (x + 0.044715f * x * x * x); return x * sigmoidf_(2.f * u); }
DI void unpack8(const u32x4 v, float* f) {
    f[0] = bf2f(v.x & 0xffffu); f[1] = __uint_as_float(v.x & 0xffff0000u); f[2] = bf2f(v.y & 0xffffu); f[3] = __uint_as_float(v.y & 0xffff0000u);
    f[4] = bf2f(v.z & 0xffffu); f[5] = __uint_as_float(v.z & 0xffff0000u); f[6] = bf2f(v.w & 0xffffu); f[7] = __uint_as_float(v.w & 0xffff0000u);
}
DI float wave_sum(float v) {
#pragma unroll
    for (int o = 1; o < 64; o <<= 1) v += __shfl_xor(v, o);
    return v;
}
#define LDS_WAIT() asm volatile("s_waitcnt lgkmcnt(0)" ::: "memory")
#define LBAR() do { asm volatile("s_waitcnt lgkmcnt(0)" ::: "memory"); __builtin_amdgcn_s_barrier(); asm volatile("" ::: "memory"); } while (0)

namespace pg8 {
#define PG8_LAS __attribute__((address_space(3)))
constexpr int BM = 256, BK = 64, HALF = 128, HTB = HALF * BK * 2, STAGE_BYTES = 8 * HTB, NXCD = 8, WGM = 8;
__host__ __device__ __forceinline__ int lds_byte(int r, int c) { const int st = (r >> 4) * 2 + (c >> 5), rr = r & 15, cc = c & 31, ob = rr * 64 + cc * 2; return st * 1024 + (ob ^ (((ob >> 9) & 1) << 5)); }
__host__ __device__ __forceinline__ void stage_rc(int b, int& R, int& C) { const int st = b / 1024, sb = b % 1024, swz = sb ^ (((sb >> 9) & 1) << 5); R = (st >> 1) * 16 + swz / 64; C = (st & 1) * 32 + (swz % 64) / 2; }
__host__ __device__ __forceinline__ int perm32(int rho) { const int n = rho >> 4, i = rho & 15; return 8 * (i >> 2) + 4 * n + (i & 3); }
struct Unit { int pm, pn, kt0, nkt, kind, slot; };
struct Gemm { const bf16_t* A; const bf16_t* Bt; int M, N, K; };
struct StaticOrder {
    int nM, nN, nwg, G, c, nktf;
    __host__ __device__ void init(int M, int N, int K, int G_, int c_) { nM = M / BM; nN = N / BM; nwg = nM * nN; G = G_; c = c_; nktf = K / BK; }
    __host__ __device__ bool next(int i, Unit& u) const {
        const long L = (long)i * G + c; if (L >= nwg) return false;
        int wgid = (int)L; { const int q = nwg / NXCD, r = nwg % NXCD, xcd = wgid % NXCD, off = wgid / NXCD; wgid = (xcd < r ? xcd * (q + 1) : r * (q + 1) + (xcd - r) * q) + off; }
        const int nig = WGM * nN, gid = wgid / nig, fm = gid * WGM, gsz = (nM - fm) < WGM ? (nM - fm) : WGM;
        u.pm = fm + ((wgid % nig) % gsz); u.pn = (wgid % nig) / gsz; u.kt0 = 0; u.nkt = nktf; u.kind = 0; u.slot = 0; return true;
    }
    __device__ __forceinline__ void a_ready(const Unit&) const {}
    __device__ __forceinline__ void done(const Unit&) const {}
};

struct SKOrder {
    int P, s, e, v;
    __device__ void init(int K, int G, int v_) { P = K / (2 * BK); const long total = (long)276 * P; s = (int)(total * v_ / G); e = (int)(total * (v_ + 1) / G); v = v_; }
    __device__ bool next(int i, Unit& u) const {
        int pe = e;
        for (int k = 0;; ++k) {
            if (pe <= s) return false;
            const int un = (pe - 1) / P, ps = (s > un * P) ? s : un * P;
            if (k == i) { u.pm = un >> 2; u.pn = un & 3; u.kt0 = 2 * (ps - un * P); u.nkt = 2 * (pe - ps);
                u.kind = (pe - ps == P) ? 0 : (ps == un * P ? 1 : 2); u.slot = (u.kind == 1) ? v : v - 1; return true; }
            pe = ps;
        }
    }
    __device__ __forceinline__ void a_ready(const Unit&) const {}
    __device__ __forceinline__ void done(const Unit&) const {}
};

template <class Epi, class Sched, bool ALIGN_EPI = false, bool SP2 = false>
__device__ __forceinline__ void gemm_phase(PG8_LAS unsigned char* lds, const Gemm g, const Sched& S, const Epi& E) {
    int tid_ = threadIdx.x; asm volatile("" : "+v"(tid_));
    const int tid = tid_, wid = __builtin_amdgcn_readfirstlane(tid >> 6), lane = tid & 63, wr = wid >> 2, wc = wid & 3, fr = lane & 15, fq = lane >> 4;
    const int K = g.K;
    unsigned voffA[2], voffB[2];
#pragma unroll
    for (int i = 0; i < 2; ++i) { int R, C; stage_rc(tid * 16 + i * 8192, R, C); const int Rb = Epi::PERM ? ((R & ~31) + perm32(R & 31)) : R;
        voffA[i] = (unsigned)(R * K + C) * 2u; voffB[i] = (unsigned)(Rb * K + C) * 2u; }
    const size_t kstep = (size_t)(BK * 2);
    const size_t hstep = (size_t)HALF * K * 2;
    const size_t tstep = 2 * hstep;
    const unsigned ldsw = (unsigned)wid * 1024u;
    const int aoff = lds_byte(wr * 64 + fr, fq * 8), boff = lds_byte(wc * 32 + fr, fq * 8);
#define PG8_SA(b, h) (((b) * 2 + (h)) * HTB)
#define PG8_SB(b, h) ((4 + (b) * 2 + (h)) * HTB)
#define PG8_STAGE(bufoff, gbase, voff) do { _Pragma("unroll") for (int _i = 0; _i < 2; ++_i) \
        __builtin_amdgcn_global_load_lds((const unsigned*)((const char*)(gbase) + (voff)[_i]), (PG8_LAS unsigned*)(lds + (bufoff) + ldsw + _i * 8192), 16, 0, 0); } while (0)
#define PG8_LDA(dst, b, h) do { _Pragma("unroll") for (int m = 0; m < 4; ++m) _Pragma("unroll") for (int k = 0; k < 2; ++k) dst[m][k] = *(const PG8_LAS bf16x8*)(lds + PG8_SA(b, h) + aoff + m * 2048 + k * 1024); } while (0)
#define PG8_LDB(dst, b, h) do { _Pragma("unroll") for (int n = 0; n < 2; ++n) _Pragma("unroll") for (int k = 0; k < 2; ++k) dst[n][k] = *(const PG8_LAS bf16x8*)(lds + PG8_SB(b, h) + boff + n * 2048 + k * 1024); } while (0)
#define PG8_MMA(ai, bj, At, Bt) do { __builtin_amdgcn_s_setprio(1); _Pragma("unroll") for (int m = 0; m < 4; ++m) _Pragma("unroll") for (int n = 0; n < 2; ++n) _Pragma("unroll") for (int k = 0; k < 2; ++k) \
        acc[ai][bj][m][n] = __builtin_amdgcn_mfma_f32_16x16x32_bf16(Bt[n][k], At[m][k], acc[ai][bj][m][n], 0, 0, 0); __builtin_amdgcn_s_setprio(0); } while (0)
#define PG8_WAIT_V(n) asm volatile("s_waitcnt vmcnt(" #n ")" ::: "memory")
#define PG8_WAIT_L(n) asm volatile("s_waitcnt lgkmcnt(" #n ")" ::: "memory")
#define PG8_BAR __builtin_amdgcn_s_barrier()
#define PG8_SCHED __builtin_amdgcn_sched_barrier(0)
    Unit cur, nxt; int ui = 0;
    if (!S.next(0, cur)) return;
    f32x4 acc[2][2][4][2];
#pragma unroll
    for (int a = 0; a < 2; ++a)
#pragma unroll
        for (int b = 0; b < 2; ++b)
#pragma unroll
            for (int m = 0; m < 4; ++m)
#pragma unroll
                for (int n = 0; n < 2; ++n) acc[a][b][m][n] = (f32x4){0.f, 0.f, 0.f, 0.f};
    bf16x8 At[4][2], B0[2][2], B1[2][2];
    const char* cA = (const char*)g.A + (size_t)cur.pm * tstep + (size_t)cur.kt0 * kstep; const char* cB = (const char*)g.Bt + (size_t)cur.pn * tstep + (size_t)cur.kt0 * kstep;
    S.a_ready(cur);
    if constexpr (SP2) {
        PG8_STAGE(PG8_SB(0, 0), cB, voffB); PG8_STAGE(PG8_SB(0, 1), cB + hstep, voffB); PG8_STAGE(PG8_SA(0, 0), cA, voffA); PG8_STAGE(PG8_SA(0, 1), cA + hstep, voffA);
        if (wr == 1) PG8_BAR;
        PG8_WAIT_V(2); PG8_BAR;
        PG8_STAGE(PG8_SB(1, 0), cB + kstep, voffB); PG8_STAGE(PG8_SA(1, 0), cA + kstep, voffA); PG8_STAGE(PG8_SB(1, 1), cB + hstep + kstep, voffB);
        PG8_WAIT_V(6); PG8_BAR;
    } else {
        PG8_STAGE(PG8_SB(0, 0), cB, voffB); PG8_STAGE(PG8_SA(0, 0), cA, voffA); PG8_STAGE(PG8_SB(0, 1), cB + hstep, voffB); PG8_STAGE(PG8_SA(0, 1), cA + hstep, voffA);
        if (wr == 1) PG8_BAR;
        PG8_WAIT_V(4); PG8_BAR;
        PG8_STAGE(PG8_SB(1, 0), cB + kstep, voffB); PG8_STAGE(PG8_SA(1, 0), cA + kstep, voffA); PG8_STAGE(PG8_SB(1, 1), cB + hstep + kstep, voffB);
        PG8_WAIT_V(6); PG8_BAR;
    }
    for (;;) {
        const bool has_next = S.next(ui + 1, nxt);
        const char* nA = has_next ? (const char*)g.A + (size_t)nxt.pm * tstep + (size_t)nxt.kt0 * kstep : cA; const char* nB = has_next ? (const char*)g.Bt + (size_t)nxt.pn * tstep + (size_t)nxt.kt0 * kstep : cB;
        const int nt = cur.nkt;
        for (int t = 0; t < nt; t += 2) {
            const bool last = (t == nt - 2);
            const char* a1 = cA + (size_t)(t + 1) * kstep;
            const char* a2 = last ? nA : cA + (size_t)(t + 2) * kstep; const char* b2 = last ? nB : cB + (size_t)(t + 2) * kstep;
            const char* a3 = a2 + kstep; const char* b3 = b2 + kstep;
            if (last && has_next) S.a_ready(nxt);
            if constexpr (SP2) {
            PG8_LDB(B0, 0, 0); PG8_LDB(B1, 0, 1); PG8_SCHED; PG8_LDA(At, 0, 0); PG8_STAGE(PG8_SA(1, 1), a1 + hstep, voffA);
            PG8_WAIT_V(8); PG8_WAIT_L(0); PG8_BAR; PG8_MMA(0, 0, At, B0); PG8_MMA(0, 1, At, B1); PG8_BAR; PG8_SCHED;
            PG8_LDA(At, 0, 1); PG8_STAGE(PG8_SB(0, 0), b2, voffB); PG8_STAGE(PG8_SB(0, 1), b2 + hstep, voffB); PG8_STAGE(PG8_SA(0, 0), a2, voffA);
            PG8_WAIT_V(8); PG8_WAIT_L(0); PG8_BAR; PG8_MMA(1, 0, At, B0); PG8_MMA(1, 1, At, B1); PG8_BAR; PG8_SCHED;
            PG8_LDB(B0, 1, 0); PG8_LDB(B1, 1, 1); PG8_SCHED; PG8_LDA(At, 1, 0); PG8_STAGE(PG8_SA(0, 1), a2 + hstep, voffA);
            PG8_WAIT_V(8); PG8_WAIT_L(0); PG8_BAR; PG8_MMA(0, 0, At, B0); PG8_MMA(0, 1, At, B1); PG8_BAR; PG8_SCHED;
            PG8_LDA(At, 1, 1); PG8_STAGE(PG8_SB(1, 0), b3, voffB); PG8_STAGE(PG8_SB(1, 1), b3 + hstep, voffB); PG8_STAGE(PG8_SA(1, 0), a3, voffA);
            PG8_WAIT_V(8); PG8_WAIT_L(0); PG8_BAR; PG8_MMA(1, 0, At, B0); PG8_MMA(1, 1, At, B1); PG8_BAR; PG8_SCHED;
            } else {
            PG8_LDB(B0, 0, 0); PG8_SCHED; PG8_LDA(At, 0, 0); PG8_STAGE(PG8_SA(1, 1), a1 + hstep, voffA);
            PG8_WAIT_L(8); PG8_BAR; PG8_WAIT_L(0); PG8_MMA(0, 0, At, B0); PG8_BAR; PG8_SCHED;
            PG8_LDB(B1, 0, 1); PG8_STAGE(PG8_SB(0, 0), b2, voffB);
            PG8_BAR; PG8_WAIT_L(0); PG8_MMA(0, 1, At, B1); PG8_BAR;
            PG8_LDA(At, 0, 1); PG8_STAGE(PG8_SA(0, 0), a2, voffA);
            PG8_BAR; PG8_WAIT_L(0); PG8_MMA(1, 0, At, B0); PG8_BAR; PG8_SCHED;
            PG8_STAGE(PG8_SB(0, 1), b2 + hstep, voffB);
            PG8_WAIT_V(6); PG8_BAR; PG8_MMA(1, 1, At, B1); PG8_BAR;
            PG8_LDB(B0, 1, 0); PG8_SCHED; PG8_LDA(At, 1, 0); PG8_STAGE(PG8_SA(0, 1), a2 + hstep, voffA);
            PG8_WAIT_L(8); PG8_BAR; PG8_WAIT_L(0); PG8_MMA(0, 0, At, B0); PG8_BAR; PG8_SCHED;
            PG8_LDB(B1, 1, 1); PG8_STAGE(PG8_SB(1, 0), b3, voffB);
            PG8_BAR; PG8_WAIT_L(0); PG8_MMA(0, 1, At, B1); PG8_BAR;
            PG8_LDA(At, 1, 1); PG8_STAGE(PG8_SA(1, 0), a3, voffA);
            PG8_BAR; PG8_WAIT_L(0); PG8_MMA(1, 0, At, B0); PG8_BAR; PG8_SCHED;
            PG8_STAGE(PG8_SB(1, 1), b3 + hstep, voffB);
            PG8_WAIT_V(6); PG8_BAR; PG8_MMA(1, 1, At, B1); PG8_BAR;
            }
        }
        if constexpr (ALIGN_EPI) { if (wr == 0) PG8_BAR; }
        E(acc, cur, wr, wc, fr, fq); S.done(cur);
        if (!has_next) break;
#pragma unroll
        for (int a = 0; a < 2; ++a)
#pragma unroll
            for (int b = 0; b < 2; ++b)
#pragma unroll
                for (int m = 0; m < 4; ++m)
#pragma unroll
                    for (int n = 0; n < 2; ++n) acc[a][b][m][n] = (f32x4){0.f, 0.f, 0.f, 0.f};
        cur = nxt; cA = nA; cB = nB; ++ui;
        if constexpr (ALIGN_EPI) { if (wr == 1) PG8_BAR; }
    }
    PG8_WAIT_V(0);
    if constexpr (!ALIGN_EPI) { if (wr == 0) PG8_BAR; }
    PG8_BAR;
#undef PG8_SA
#undef PG8_SB
#undef PG8_STAGE
#undef PG8_LDA
#undef PG8_LDB
#undef PG8_MMA
#undef PG8_WAIT_V
#undef PG8_WAIT_L
#undef PG8_BAR
#undef PG8_SCHED
}

struct EpiSwiGLU {
    static constexpr bool PERM = true;
    bf16_t* H; const float* ss;
    static __device__ __forceinline__ EpiSwiGLU make(unsigned char* ws, int ssi) { return EpiSwiGLU{(bf16_t*)(ws + WS_HU), (const float*)(ws + WS_SS) + (size_t)ssi * MPAD}; }
    __device__ __forceinline__ void operator()(const f32x4 (&acc)[2][2][4][2], const Unit& u, int wr, int wc, int fr, int fq) const {
        const int row0 = u.pm * BM + wr * 64 + fr, col0 = u.pn * 128 + wc * 32 + 8 * fq;
#pragma unroll
        for (int ai = 0; ai < 2; ++ai)
#pragma unroll
            for (int m = 0; m < 4; ++m) {
                const int row = row0 + ai * HALF + m * 16;
                const float rs = rsqrtf(ss[row] * (1.f / DM) + EPS);
                float h[8];
#pragma unroll
                for (int n = 0; n < 2; ++n)
#pragma unroll
                    for (int j = 0; j < 4; ++j) { const float gg = acc[ai][0][m][n][j] * rs, uu = acc[ai][1][m][n][j] * rs; h[4 * n + j] = siluf_(gg) * uu; }
                u32x4 w; w.x = cvt_pk(h[0], h[1]); w.y = cvt_pk(h[2], h[3]); w.z = cvt_pk(h[4], h[5]); w.w = cvt_pk(h[6], h[7]);
                *(u32x4*)(H + (size_t)row * DFF + col0) = w;
            }
    }
};
struct EpiRowScale {
    static constexpr bool PERM = true;
    bf16_t* O; int ldc; const float* ss;
    static __device__ __forceinline__ EpiRowScale make(unsigned char* ws, int ssi) { return EpiRowScale{(bf16_t*)(ws + WS_HU), UN, (const float*)(ws + WS_SS) + (size_t)ssi * MPAD}; }
    __device__ __forceinline__ void operator()(const f32x4 (&acc)[2][2][4][2], const Unit& u, int wr, int wc, int fr, int fq) const {
        const int row0 = u.pm * BM + wr * 64 + fr, col0 = u.pn * BM + wc * 32 + 8 * fq;
#pragma unroll
        for (int ai = 0; ai < 2; ++ai)
#pragma unroll
            for (int m = 0; m < 4; ++m) {
                const int row = row0 + ai * HALF + m * 16;
                const float rs = rsqrtf(ss[row] * (1.f / DM) + EPS);
#pragma unroll
                for (int bj = 0; bj < 2; ++bj) {
                    const f32x4 v0 = acc[ai][bj][m][0] * rs, v1 = acc[ai][bj][m][1] * rs;
                    u32x4 w; w.x = cvt_pk(v0[0], v0[1]); w.y = cvt_pk(v0[2], v0[3]); w.z = cvt_pk(v1[0], v1[1]); w.w = cvt_pk(v1[2], v1[3]);
                    *(u32x4*)(O + (size_t)row * ldc + col0 + bj * HALF) = w;
                }
            }
    }
};
struct EpiRes {
    static constexpr bool PERM = true;
    bf16_t* X; float* ssn; float scale; float* part; unsigned* flags; unsigned epoch;
    static __device__ __forceinline__ EpiRes make(unsigned char* ws, int ssi, float sc, size_t part_off, unsigned ep) {
        return EpiRes{(bf16_t*)(ws + WS_XB), (float*)(ws + WS_SS) + (size_t)ssi * MPAD, sc, (float*)(ws + part_off), (unsigned*)(ws + WS_FLAGS), ep}; }
    __device__ __forceinline__ void operator()(const f32x4 (&acc)[2][2][4][2], const Unit& u, int wr, int wc, int fr, int fq) const {
        const int wid = wr * 4 + wc, lane = fr + 16 * fq;
        if (u.kind == 1) {
            const u32x4* dst = (const u32x4*)(part + (size_t)u.slot * 32768) + (size_t)wid * 1024 + lane;
#pragma unroll
            for (int ai = 0; ai < 2; ++ai)
#pragma unroll
                for (int bj = 0; bj < 2; ++bj)
#pragma unroll
                    for (int m = 0; m < 4; ++m) { const int c = (ai * 2 + bj) * 4 + m; const f32x4 a0 = acc[ai][bj][m][0], a1 = acc[ai][bj][m][1];
                        u32x4 w; w.x = cvt_pk(a0[0], a0[1]); w.y = cvt_pk(a0[2], a0[3]); w.z = cvt_pk(a1[0], a1[1]); w.w = cvt_pk(a1[2], a1[3]);
                        asm volatile("global_store_dwordx4 %0, %1, off sc1" :: "v"(dst + c * 64), "v"(w) : "memory"); }
            asm volatile("s_waitcnt vmcnt(0)" ::: "memory");
            __syncthreads();
            if (wid == 0 && lane == 0) __hip_atomic_store(flags + u.slot * 16, epoch, __ATOMIC_RELAXED, __HIP_MEMORY_SCOPE_AGENT);
            return;
        }
        const u32x4* src = nullptr;
        if (u.kind == 2) {
            if (wid == 0 && lane == 0) { unsigned sp = 0; while (__hip_atomic_load(flags + u.slot * 16, __ATOMIC_RELAXED, __HIP_MEMORY_SCOPE_AGENT) != epoch) { __builtin_amdgcn_s_sleep(2); if (++sp > (1u << 22)) break; } }
            __syncthreads();
            src = (const u32x4*)(part + (size_t)u.slot * 32768) + (size_t)wid * 1024 + lane;
        }
        const int row0 = u.pm * BM + wr * 64 + fr, col0 = u.pn * BM + wc * 32 + 8 * fq;
#pragma unroll
        for (int ai = 0; ai < 2; ++ai)
#pragma unroll
            for (int mp = 0; mp < 2; ++mp) {
                u32x4 xin[2][2];
#pragma unroll
                for (int mm = 0; mm < 2; ++mm)
#pragma unroll
                    for (int bj = 0; bj < 2; ++bj) xin[mm][bj] = *(const u32x4*)(X + (size_t)(row0 + ai * HALF + (mp * 2 + mm) * 16) * DM + col0 + bj * HALF);
                f32x4 pv[2][2][2];
#pragma unroll
                for (int mm = 0; mm < 2; ++mm)
#pragma unroll
                    for (int bj = 0; bj < 2; ++bj)
#pragma unroll
                        for (int n = 0; n < 2; ++n) pv[mm][bj][n] = (f32x4){0.f, 0.f, 0.f, 0.f};
                if (src) {
                    u32x4 pc[2][2];
#define CI(mm, bj) ((((ai * 2 + (bj)) * 4 + mp * 2 + (mm))) * 64)
                    asm volatile("global_load_dwordx4 %0, %4, off sc1\n\tglobal_load_dwordx4 %1, %5, off sc1\n\tglobal_load_dwordx4 %2, %6, off sc1\n\tglobal_load_dwordx4 %3, %7, off sc1\n\ts_waitcnt vmcnt(0)"
                                 : "=&v"(pc[0][0]), "=&v"(pc[0][1]), "=&v"(pc[1][0]), "=&v"(pc[1][1])
                                 : "v"(src + CI(0, 0)), "v"(src + CI(0, 1)), "v"(src + CI(1, 0)), "v"(src + CI(1, 1))
                                 : "memory");
#undef CI
#pragma unroll
                    for (int mm = 0; mm < 2; ++mm)
#pragma unroll
                        for (int bj = 0; bj < 2; ++bj) { float f[8]; unpack8(pc[mm][bj], f); pv[mm][bj][0] = (f32x4){f[0], f[1], f[2], f[3]}; pv[mm][bj][1] = (f32x4){f[4], f[5], f[6], f[7]}; }
                }
#pragma unroll
                for (int mm = 0; mm < 2; ++mm) {
                    const int m = mp * 2 + mm;
                    const int row = row0 + ai * HALF + m * 16;
                    float s = 0.f;
#pragma unroll
                    for (int bj = 0; bj < 2; ++bj) {
                        u32x4* px = (u32x4*)(X + (size_t)row * DM + col0 + bj * HALF);
                        float xo[8]; unpack8(xin[mm][bj], xo);
                        const f32x4 a0 = acc[ai][bj][m][0] + pv[mm][bj][0], a1 = acc[ai][bj][m][1] + pv[mm][bj][1];
                        u32x4 w;
                        w.x = cvt_pk(xo[0] + scale * a0[0], xo[1] + scale * a0[1]); w.y = cvt_pk(xo[2] + scale * a0[2], xo[3] + scale * a0[3]);
                        w.z = cvt_pk(xo[4] + scale * a1[0], xo[5] + scale * a1[1]); w.w = cvt_pk(xo[6] + scale * a1[2], xo[7] + scale * a1[3]);
                        *px = w;
                        float xn[8]; unpack8(w, xn);
#pragma unroll
                        for (int j = 0; j < 8; ++j) s += xn[j] * xn[j];
                    }
                    s += __shfl_xor(s, 16); s += __shfl_xor(s, 32);
                    if (fq == 0) unsafeAtomicAdd(ssn + row, s);
                }
            }
    }
};
}

struct Args { const float* in[26]; float* out; unsigned char* ws; };
typedef const __attribute__((address_space(4))) Args* KA;
DI KA get_ka() { KA p = (KA)__builtin_amdgcn_kernarg_segment_ptr(); asm volatile("" : "+s"(p)); return p; }
DI int opaque_tid() { int t = threadIdx.x; asm volatile("" : "+v"(t)); return t; }

template <int MODE  >
DI void transpose_item(const float* __restrict__ W, const float* __restrict__ gk, int K, int N, bf16_t* WT, LAS float* scr, int item, int lane) {
    const int nblk = (N + 31) / 32, kb = item / nblk, nb = item % nblk, k0 = 64 * kb, n0 = 32 * nb;
    const int kr = lane >> 3, c4 = (lane & 7) * 4;
    f32x4 wv[8];
#pragma unroll
    for (int i = 0; i < 8; ++i) wv[i] = (n0 + c4 < N) ? __builtin_nontemporal_load((const f32x4*)(W + (size_t)(k0 + 8 * i + kr) * N + n0 + c4)) : (f32x4){0.f, 0.f, 0.f, 0.f};
    if (gk) {
#pragma unroll
        for (int i = 0; i < 8; ++i) wv[i] = wv[i] * gk[k0 + 8 * i + kr];
    }
#pragma unroll
    for (int i = 0; i < 8; ++i) { LAS float* d = scr + (8 * i + kr) * 33 + c4; d[0] = wv[i].x; d[1] = wv[i].y; d[2] = wv[i].z; d[3] = wv[i].w; }
    LDS_WAIT(); asm volatile("" ::: "memory");
    const int c = lane & 7;
#pragma unroll
    for (int j = 0; j < 4; ++j) { const int n = (lane >> 3) + 8 * j; const LAS float* s = scr + (8 * c) * 33 + n;
        u32x4 o; o.x = cvt_pk(s[0 * 33], s[1 * 33]); o.y = cvt_pk(s[2 * 33], s[3 * 33]); o.z = cvt_pk(s[4 * 33], s[5 * 33]); o.w = cvt_pk(s[6 * 33], s[7 * 33]);
        int dn = n0 + n;
        if (MODE == 1) { const int up = dn >= DFF ? 1 : 0, jn = dn - up * DFF; dn = 256 * (jn >> 7) + 128 * up + (jn & 127); }
        *(u32x4*)(WT + (size_t)dn * K + k0 + 8 * c) = o; }
    LDS_WAIT(); asm volatile("" ::: "memory");
}

constexpr int IT_GU = (DM / 64) * (2 * DFF / 32);
constexpr int IT_D = (DFF / 64) * (DM / 32);
constexpr int IT_IN = (DM / 64) * ((DIN + 31) / 32);
constexpr int IT_OUT = (DM / 64) * (DM / 32);
constexpr int IT_LAYER = 2 * IT_GU + 2 * IT_D + IT_IN + IT_OUT;

DI void convert_layer_weights(KA a, int l, LAS unsigned char* lds, int gw, int NGW, int wave, int lane) {
    LAS float* scr = (LAS float*)(lds + wave * 8704);
    unsigned char* ws = a->ws;
    for (int it = gw; it < IT_LAYER; it += NGW) {
        int r = it;
        if (r < IT_GU) { transpose_item<1>(a->in[7] + (size_t)l * DM * 2 * DFF, a->in[6] + l * DM, DM, 2 * DFF, (bf16_t*)(ws + WS_WGU1), scr, r, lane); continue; } r -= IT_GU;
        if (r < IT_GU) { transpose_item<1>(a->in[23] + (size_t)l * DM * 2 * DFF, a->in[22] + l * DM, DM, 2 * DFF, (bf16_t*)(ws + WS_WGU2), scr, r, lane); continue; } r -= IT_GU;
        if (r < IT_D) { transpose_item<0>(a->in[8] + (size_t)l * DFF * DM, nullptr, DFF, DM, (bf16_t*)(ws + WS_WD1), scr, r, lane); continue; } r -= IT_D;
        if (r < IT_D) { transpose_item<0>(a->in[24] + (size_t)l * DFF * DM, nullptr, DFF, DM, (bf16_t*)(ws + WS_WD2), scr, r, lane); continue; } r -= IT_D;
        if (r < IT_IN) { transpose_item<0>(a->in[10] + (size_t)l * DM * DIN, a->in[9] + l * DM, DM, DIN, (bf16_t*)(ws + WS_WIN), scr, r, lane); continue; } r -= IT_IN;
        transpose_item<0>(a->in[21] + (size_t)l * DM * DM, nullptr, DM, DM, (bf16_t*)(ws + WS_WOUT), scr, r, lane);
    }
}

DI void prologue(KA a, LAS unsigned char* lds) {
    const int tid = opaque_tid(), lane = tid & 63, wave = tid >> 6;
    const int G = gridDim.x, gw = blockIdx.x * 8 + wave, NGW = G * 8;
    const int gt = blockIdx.x * 512 + tid, NGT = G * 512;
    unsigned char* ws = a->ws;
    { float* ss = (float*)(ws + WS_SS); for (int i = gt; i < 6 * MPAD; i += NGT) ss[MPAD + i] = 0.f; }
    { u32x4* p = (u32x4*)((bf16_t*)(ws + WS_WIN) + (size_t)2592 * DM); const int n = (UN - 2592) * DM / 8; for (int i = gt; i < n; i += NGT) p[i] = (u32x4){0u, 0u, 0u, 0u}; }
    { u32x4* p = (u32x4*)((bf16_t*)(ws + WS_Y) + (size_t)MTOK * DM); const int n = (MPAD - MTOK) * DM / 8; for (int i = gt; i < n; i += NGT) p[i] = (u32x4){0u, 0u, 0u, 0u}; }
    { bf16_t* wt = (bf16_t*)(ws + WS_WAT);
      for (int i = gt; i < 2 * 2 * 8 * 64 * 64; i += NGT) { const int k = i & 63, n = (i >> 6) & 63, blk = (i >> 12) & 7, g = (i >> 15) & 1, l = i >> 16;
          const float* src = g ? a->in[15] : a->in[13]; wt[i] = f2bf(src[((size_t)(l * 8 + blk) * 64 + k) * 64 + n]); } }
    convert_layer_weights(a, 0, lds, gw, NGW, wave, lane);
    { bf16_t* XB = (bf16_t*)(ws + WS_XB); float* ss0 = (float*)(ws + WS_SS);
      for (int rowb = gw; rowb < MPAD; rowb += 2 * NGW) {
          const float* src[2]; f32x4 v[2][4];
#pragma unroll
          for (int q = 0; q < 2; ++q) {
              const int row = rowb + q * NGW;
              src[q] = nullptr;
              if (row < MP) { const int b = row / LP, t = row - b * LP; src[q] = t < NMETA ? a->in[5] + (size_t)t * DM : a->in[0] + ((size_t)b * SEQ + (t - NMETA)) * DM; }
              else if (row < MTOK) src[q] = a->in[1] + (size_t)(row - MP) * DM;
#pragma unroll
              for (int j = 0; j < 4; ++j) v[q][j] = src[q] ? __builtin_nontemporal_load((const f32x4*)src[q] + lane + 64 * j) : (f32x4){0.f, 0.f, 0.f, 0.f};
          }
#pragma unroll
          for (int q = 0; q < 2; ++q) {
              const int row = rowb + q * NGW;
              if (row < MPAD) {
                  float s = 0.f;
                  u32x2* dst = (u32x2*)(XB + (size_t)row * DM) + lane;
#pragma unroll
                  for (int j = 0; j < 4; ++j) {
                      u32x2 o; o.x = cvt_pk(v[q][j].x, v[q][j].y); o.y = cvt_pk(v[q][j].z, v[q][j].w);
                      dst[64 * j] = o;
                      const float r0 = bf2f(o.x & 0xffffu), r1 = __uint_as_float(o.x & 0xffff0000u), r2 = bf2f(o.y & 0xffffu), r3 = __uint_as_float(o.y & 0xffff0000u);
                      s += r0 * r0 + r1 * r1 + r2 * r2 + r3 * r3;
                  }
                  s = wave_sum(s);
                  if (lane == 0) ss0[row] = s;
              }
          }
      } }
}

DI int crow(int reg, int h) { return (reg & 3) + 8 * (reg >> 2) + 4 * h; }
DI void mma_blk(f32x16& acc, const LAS bf16_t* A, const LAS bf16_t* B, int r, int h) {
#pragma unroll
    for (int ks = 0; ks < 4; ++ks) {
        const bf16x8 av = *(const LAS bf16x8*)(A + r * 72 + ks * 16 + 8 * h);
        const bf16x8 bv = *(const LAS bf16x8*)(B + r * 72 + ks * 16 + 8 * h);
        acc = __builtin_amdgcn_mfma_f32_32x32x16_bf16(av, bv, acc, 0, 0, 0);
    }
}
struct UnitInfo { int row0, nvalid, prompt, b, c, s; };
DI UnitInfo decode_unit(int unit) {
    UnitInfo u;
    if (unit < NUNIT_P) { u.prompt = 1; u.b = unit / NCH; u.c = unit - u.b * NCH; u.s = 0; const int tau0 = u.c == 0 ? 0 : NMETA + 64 * (u.c - 1); u.nvalid = u.c == 0 ? NMETA : 64; u.row0 = u.b * LP + tau0; }
    else { u.prompt = 0; u.s = unit - NUNIT_P; u.b = 0; u.c = 0; u.row0 = MP + LS * u.s; u.nvalid = LS; }
    return u;
}

template <bool FINAL>
DI void lru_unit(KA a, int l, int unit, LAS unsigned char* lds) {
    const UnitInfo u = decode_unit(unit);
    const int tid = opaque_tid(), lane = tid & 63, w = __builtin_amdgcn_readfirstlane(tid >> 6), r = lane & 31, h = lane >> 5;
    const bf16_t* U = (const bf16_t*)(a->ws + WS_HU);
    LAS bf16_t* xc = (LAS bf16_t*)lds + w * (64 * 72);
    LAS unsigned char* wsc = lds + 73728 + w * 8192;
    LAS bf16_t* xr = (LAS bf16_t*)wsc;
    const int row0 = u.row0, nvalid = u.nvalid;
    const bool lastc = u.prompt ? (u.c == NCH - 1) : true;
    float* out = a->out;
    const bf16_t* WaT = (const bf16_t*)(a->ws + WS_WAT) + ((size_t)(l * 2 + 0) * 8 + w) * 4096;
    const bf16_t* WxT = (const bf16_t*)(a->ws + WS_WAT) + ((size_t)(l * 2 + 1) * 8 + w) * 4096;
    {
        const int tr = lane >> 3, cg8 = (lane & 7) * 8;
        const bf16_t* src = U + (size_t)(row0 + tr) * UN + 64 * w + cg8;
        u32x4 v[8];
#pragma unroll
        for (int k = 0; k < 8; ++k) { v[k] = (u32x4){0u, 0u, 0u, 0u}; if (8 * k + tr < nvalid) v[k] = *(const u32x4*)(src + (size_t)(8 * k) * UN); }
#pragma unroll
        for (int k = 0; k < 8; ++k) *(LAS u32x4*)(xr + (8 * k + tr) * 64 + cg8) = v[k];
    }
    {
        const int ch = 64 * w + lane;
        const float* cw = a->in[11] + (size_t)l * 4 * DLRU;
        const float cw0 = cw[ch], cw1 = cw[DLRU + ch], cw2 = cw[2 * DLRU + ch], cw3 = cw[3 * DLRU + ch], cb = a->in[12][l * DLRU + ch];
        float xm3 = 0.f, xm2 = 0.f, xm1 = 0.f;
        if (u.prompt) { if (u.c > 0) { xm3 = bf2f(U[(size_t)(row0 - 3) * UN + ch]); xm2 = bf2f(U[(size_t)(row0 - 2) * UN + ch]); xm1 = bf2f(U[(size_t)(row0 - 1) * UN + ch]); } }
        else { const float* cs = a->in[3] + ((size_t)(l * NSB + u.s) * 3) * DLRU + ch; xm3 = cs[0]; xm2 = cs[DLRU]; xm1 = cs[2 * DLRU]; }
        float* cout = out + (u.prompt ? O_CP + (size_t)(l * NB + u.b) * 3 * DLRU : O_CS + (size_t)(l * NSB + u.s) * 3 * DLRU) + ch;
        LDS_WAIT(); asm volatile("" ::: "memory");
#pragma unroll 8
        for (int t = 0; t < 64; ++t) {
            const float xv = bf2f(xr[t * 64 + lane]);
            const float xcv = cb + cw0 * xm3 + cw1 * xm2 + cw2 * xm1 + cw3 * xv;
            xc[t * 72 + lane] = (t < nvalid) ? f2bf(xcv) : (bf16_t)0;
            xm3 = xm2; xm2 = xm1; xm1 = xv;
            if (FINAL && lastc && t >= nvalid - 3 && t < nvalid) cout[(size_t)(t - (nvalid - 3)) * DLRU] = xv;
        }
    }
    LDS_WAIT(); asm volatile("" ::: "memory");
    const int taur = 16 * ((r >> 2) & 1) + 4 * (r >> 3) + (r & 3);
#pragma unroll 1
    for (int nb = 0; nb < 2; ++nb) {
        f32x16 ar[2], ai[2];
#pragma unroll
        for (int i = 0; i < 16; ++i) { ar[0][i] = 0.f; ar[1][i] = 0.f; ai[0][i] = 0.f; ai[1][i] = 0.f; }
        u32x4 gv[4];
        if (FINAL) {
            const bf16_t* gp = U + (size_t)(row0 + (lane >> 2)) * UN + U_GL + 64 * w + 32 * nb + (lane & 3) * 8;
#pragma unroll
            for (int p = 0; p < 4; ++p) { gv[p] = (u32x4){0u, 0u, 0u, 0u}; if (16 * p + (lane >> 2) < nvalid) gv[p] = *(const u32x4*)(gp + (size_t)(16 * p) * UN); }
        }
#pragma unroll
        for (int ks = 0; ks < 4; ++ks) {
            const bf16x8 ba = *(const bf16x8*)(WaT + (nb * 32 + r) * 64 + ks * 16 + 8 * h);
            const bf16x8 bx = *(const bf16x8*)(WxT + (nb * 32 + r) * 64 + ks * 16 + 8 * h);
#pragma unroll
            for (int mb = 0; mb < 2; ++mb) {
                const bf16x8 av = *(const LAS bf16x8*)(xc + (mb * 32 + taur) * 72 + ks * 16 + 8 * h);
                ar[mb] = __builtin_amdgcn_mfma_f32_32x32x16_bf16(av, ba, ar[mb], 0, 0, 0);
                ai[mb] = __builtin_amdgcn_mfma_f32_32x32x16_bf16(av, bx, ai[mb], 0, 0, 0);
            }
        }
        const int cl = 32 * nb + r, chn = 64 * w + cl;
        const float ba_ = a->in[14][l * DLRU + chn], bx_ = a->in[16][l * DLRU + chn];
        const float c8 = -8.f * log1pf(__expf(-a->in[17][l * DLRU + chn]));
        float cin = 0.f;
        if (FINAL && !u.prompt) cin = a->in[2][(size_t)(l * NSB + u.s) * DLRU + chn];
#pragma unroll
        for (int mb = 0; mb < 2; ++mb) {
            float pp = 1.f, hh = 0.f;
#pragma unroll
            for (int i = 0; i < 16; ++i) {
                const int t = 32 * mb + 16 * h + i;
                const float rg = sigmoidf_(ar[mb][i] + ba_), ig = sigmoidf_(ai[mb][i] + bx_);
                const float la = c8 * rg;
                float av = __expf(la), mult = __builtin_amdgcn_sqrtf(fmaxf(1.f - av * av, 0.f));
                const float xcv = bf2f(xc[t * 72 + cl]);
                float bt = mult * ig * xcv;
                if (u.prompt && u.c == 0 && t == 0) { av = 0.f; bt = ig * xcv; }
                if (t >= nvalid) { av = 1.f; bt = 0.f; }
                hh = av * hh + bt; pp *= av;
                ar[mb][i] = pp; ai[mb][i] = hh;
            }
        }
        const float PA = ar[0][15], HA = ai[0][15], PB = ar[1][15], HB = ai[1][15];
        const float PAo = __shfl_xor(PA, 32), HAo = __shfl_xor(HA, 32), PBo = __shfl_xor(PB, 32), HBo = __shfl_xor(HB, 32);
        const float P0 = h ? PAo : PA, H0 = h ? HAo : HA, P1 = h ? PA : PAo, H1 = h ? HA : HAo;
        const float P2 = h ? PBo : PB, H2 = h ? HBo : HB, P3 = h ? PB : PBo, H3 = h ? HB : HBo;
        {
            if (u.prompt) {
                unsigned long long* ls = (unsigned long long*)(a->ws + WS_LSUM);
                unsigned* lf = (unsigned*)(a->ws + WS_LFLAG);
                const unsigned epoch = (unsigned)l + 1u;
                if (u.c < NCH - 1) {
                    const float Pt = P0 * P1 * P2 * P3, Ht = ((H0 * P1 + H1) * P2 + H2) * P3 + H3;
                    if (h == 0) __hip_atomic_store(ls + (size_t)unit * DLRU + chn, (unsigned long long)__float_as_uint(Pt) | ((unsigned long long)__float_as_uint(Ht) << 32), __ATOMIC_RELAXED, __HIP_MEMORY_SCOPE_AGENT);
                    asm volatile("s_waitcnt vmcnt(0)" ::: "memory");
                    if (lane == 0) __hip_atomic_store(lf + ((size_t)unit * 8 + w) * 2 + nb, epoch, __ATOMIC_RELAXED, __HIP_MEMORY_SCOPE_AGENT);
                }
                if (u.c > 0) {
                    {
                        const unsigned* fp = lf + ((size_t)(u.b * NCH + (lane < u.c ? lane : 0)) * 8 + w) * 2 + nb;
                        unsigned sp = 0;
                        for (;;) {
                            const bool ok = (lane >= u.c) || (__hip_atomic_load(fp, __ATOMIC_RELAXED, __HIP_MEMORY_SCOPE_AGENT) == epoch);
                            if (__all(ok)) break;
                            __builtin_amdgcn_s_sleep(2);
                            if (++sp > (1u << 22)) break;
                        }
                    }
                    const unsigned long long* lp = ls + (size_t)(u.b * NCH) * DLRU + chn;
                    for (int c0 = 0; c0 < u.c; c0 += 8) {
                        unsigned long long pv[8];
#pragma unroll
                        for (int k = 0; k < 8; ++k) { pv[k] = 0x3f800000ull; if (c0 + k < u.c) pv[k] = __hip_atomic_load(lp + (size_t)(c0 + k) * DLRU, __ATOMIC_RELAXED, __HIP_MEMORY_SCOPE_AGENT); }
#pragma unroll
                        for (int k = 0; k < 8; ++k) cin = __uint_as_float((unsigned)pv[k]) * cin + __uint_as_float((unsigned)(pv[k] >> 32));
                    }
                }
            }
            const float c1 = P0 * cin + H0, c2 = P1 * c1 + H1, c3 = P2 * c2 + H2;
            const float cA = h ? c1 : cin, cB = h ? c3 : c2;
            bf16_t* Y = (bf16_t*)(a->ws + WS_Y);
            float* hout = out + (u.prompt ? O_HP + (size_t)(l * NB + u.b) * DLRU : O_HS + (size_t)(l * NSB + u.s) * DLRU) + chn;
            LAS float* hb = (LAS float*)wsc;
#pragma unroll
            for (int mb = 0; mb < 2; ++mb)
#pragma unroll
                for (int i = 0; i < 16; ++i) hb[(32 * mb + 16 * h + i) * 32 + r] = ai[mb][i] + ar[mb][i] * (mb ? cB : cA);
            LDS_WAIT(); asm volatile("" ::: "memory");
            if (lastc && h == 0) *hout = hb[(nvalid - 1) * 32 + r];
            {
                const int tr = lane >> 2, c8o = (lane & 3) * 8;
                bf16_t* yp = Y + (size_t)(row0 + tr) * DM + 64 * w + 32 * nb + c8o;
#pragma unroll
                for (int p = 0; p < 4; ++p) {
                    if (16 * p + tr < nvalid) {
                        const f32x4 h0 = *(const LAS f32x4*)(hb + (16 * p + tr) * 32 + c8o), h1 = *(const LAS f32x4*)(hb + (16 * p + tr) * 32 + c8o + 4);
                        float g[8]; unpack8(gv[p], g);
                        u32x4 o; o.x = cvt_pk(h0.x * gelu_tanh(g[0]), h0.y * gelu_tanh(g[1])); o.y = cvt_pk(h0.z * gelu_tanh(g[2]), h0.w * gelu_tanh(g[3]));
                        o.z = cvt_pk(h1.x * gelu_tanh(g[4]), h1.y * gelu_tanh(g[5])); o.w = cvt_pk(h1.z * gelu_tanh(g[6]), h1.w * gelu_tanh(g[7]));
                        *(u32x4*)(yp + (size_t)(16 * p) * DM) = o;
                    }
                }
            }
            LDS_WAIT(); asm volatile("" ::: "memory");
        }
    }
}

constexpr int GL_GSUM = 0, GL_DS = 2048, GL_QS = 4096, GL_KS = 13312, GL_VT = 22528, GL_ST = 40960, GL_ATT = 59392, GL_OB = 68608;
DI void mma_blk_swz(f32x16& acc, const LAS bf16_t* A, const LAS bf16_t* Bsw, int r, int h, int rowB0) {
    const int swz = ((rowB0 + r) >> 4) & 7;
#pragma unroll
    for (int ks = 0; ks < 4; ++ks) {
        const bf16x8 av = *(const LAS bf16x8*)(A + r * 72 + ks * 16 + 8 * h);
        const bf16x8 bv = *(const LAS bf16x8*)(Bsw + (rowB0 + r) * 72 + (((2 * ks + h) ^ swz) << 3));
        acc = __builtin_amdgcn_mfma_f32_32x32x16_bf16(av, bv, acc, 0, 0, 0);
    }
}
constexpr int GL_HEAD = 68608;
template <bool FINAL>
DI void gla_unit(KA a, int l, int item, LAS unsigned char* lds) {
    const int unit = item >> 1, hp = item & 1;
    const UnitInfo u = decode_unit(unit);
    const int tid = opaque_tid(), lane = tid & 63, w = __builtin_amdgcn_readfirstlane(tid >> 6), r = lane & 31, h = lane >> 5;
    const bf16_t* U = (const bf16_t*)(a->ws + WS_HU);
    const int row0 = u.row0, nvalid = u.nvalid;
    const int dk = lane, tg = w;
    const int vj = tid >> 3, vdvc = (tid & 7) * 16;
    unsigned kraw[2][8], qraw[2][8];
    u32x4 v0[2], v1[2], g0[2], g1[2];
    f32x4 sv[2][4];
    const float* S0[2];
#pragma unroll
    for (int hh = 0; hh < 2; ++hh) {
        const int hd = 2 * hp + hh;
#pragma unroll
        for (int jj = 0; jj < 8; ++jj) {
            const int t = 8 * tg + jj; kraw[hh][jj] = 0u; qraw[hh][jj] = 0u;
            if (t < nvalid) { kraw[hh][jj] = U[(size_t)(row0 + t) * UN + U_K + hd * 64 + dk]; if (FINAL) qraw[hh][jj] = U[(size_t)(row0 + t) * UN + U_Q + hd * 64 + dk]; }
        }
        v0[hh] = (u32x4){0u, 0u, 0u, 0u}; v1[hh] = v0[hh]; g0[hh] = v0[hh]; g1[hh] = v0[hh];
        if (vj < nvalid) {
            const u32x4* vp = (const u32x4*)(U + (size_t)(row0 + vj) * UN + U_V + hd * 128 + vdvc); v0[hh] = vp[0]; v1[hh] = vp[1];
            if (FINAL) { const u32x4* gp = (const u32x4*)(U + (size_t)(row0 + vj) * UN + U_GO + hd * 128 + vdvc); g0[hh] = gp[0]; g1[hh] = gp[1]; }
        }
        S0[hh] = nullptr;
        if (!u.prompt) S0[hh] = a->in[4] + (size_t)((l * NSB + u.s) * 4 + hd) * 8192;
        if (FINAL) {
            const bf16_t* Sb = (u.prompt && u.c > 0) ? (const bf16_t*)(a->ws + WS_SB) + (size_t)(unit * 4 + hd) * 8192 : nullptr;
#pragma unroll
            for (int it = 0; it < 4; ++it) {
                const int idx = it * 512 + tid; sv[hh][it] = (f32x4){0.f, 0.f, 0.f, 0.f};
                if (S0[hh]) sv[hh][it] = *(const f32x4*)(S0[hh] + (idx >> 5) * 128 + (idx & 31) * 4);
                else if (Sb) { const u32x2 v = *(const u32x2*)(Sb + (idx >> 5) * 128 + (idx & 31) * 4); sv[hh][it] = (f32x4){bf2f(v.x & 0xffffu), __uint_as_float(v.x & 0xffff0000u), bf2f(v.y & 0xffffu), __uint_as_float(v.y & 0xffff0000u)}; }
            }
        }
    }
    f32x4 gnv[4];
    if (FINAL) {
#pragma unroll
        for (int q = 0; q < 4; ++q) gnv[q] = *(const f32x4*)(a->in[20] + l * DV + vdvc + 4 * q);
    }
    float s0v[2][16];
    if (!FINAL && !u.prompt) {
#pragma unroll
        for (int hh = 0; hh < 2; ++hh)
#pragma unroll
            for (int i = 0; i < 16; ++i) s0v[hh][i] = __builtin_nontemporal_load(S0[hh] + (32 * (w >> 2) + crow(i, h)) * 128 + 32 * (w & 3) + r);
    }
    float bl[2][8];
    {
        float wg[2][16], bg[2];
#pragma unroll
        for (int hh = 0; hh < 2; ++hh) {
            const float* wg2 = a->in[18] + (size_t)l * 16 * 256 + (2 * hp + hh) * 64 + dk;
#pragma unroll
            for (int e = 0; e < 16; ++e) wg[hh][e] = wg2[e * 256];
            bg[hh] = a->in[19][l * 256 + (2 * hp + hh) * 64 + dk];
        }
        float run0 = 0.f, run1 = 0.f;
#pragma unroll
        for (int jj = 0; jj < 8; ++jj) {
            const int t = 8 * tg + jj;
            float ga = 0.f, gb = 0.f;
            if (t < nvalid) {
                const u32x4* lp = (const u32x4*)(U + (size_t)(row0 + t) * UN + U_LR);
                float lr[16]; unpack8(lp[0], lr); unpack8(lp[1], lr + 8);
                float za = bg[0], zb = bg[1];
#pragma unroll
                for (int e = 0; e < 16; ++e) { za += wg[0][e] * lr[e]; zb += wg[1][e] * lr[e]; }
                ga = (fminf(za, 0.f) - __logf(1.f + __expf(-fabsf(za)))) * (1.f / 16.f);
                gb = (fminf(zb, 0.f) - __logf(1.f + __expf(-fabsf(zb)))) * (1.f / 16.f);
            }
            run0 += ga; run1 += gb; bl[0][jj] = run0; bl[1][jj] = run1;
        }
        ((LAS float*)(lds + GL_GSUM))[tg * 64 + dk] = run0;
        ((LAS float*)(lds + GL_HEAD + GL_GSUM))[tg * 64 + dk] = run1;
    }
#pragma unroll
    for (int hh = 0; hh < 2; ++hh) {
        LAS bf16_t* vT = (LAS bf16_t*)(lds + hh * GL_HEAD + GL_VT); LAS bf16_t* sT = (LAS bf16_t*)(lds + hh * GL_HEAD + GL_ST);
        {
            const unsigned vv[8] = {v0[hh].x, v0[hh].y, v0[hh].z, v0[hh].w, v1[hh].x, v1[hh].y, v1[hh].z, v1[hh].w};
            const int col = ((((vj >> 3) ^ ((vdvc >> 4) & 7)) << 3) | (vj & 7));
#pragma unroll
            for (int e = 0; e < 8; ++e) { vT[(vdvc + 2 * e) * 72 + col] = (bf16_t)(vv[e] & 0xffffu); vT[(vdvc + 2 * e + 1) * 72 + col] = (bf16_t)(vv[e] >> 16); }
        }
        if (FINAL) {
#pragma unroll
            for (int it = 0; it < 4; ++it) {
                const int idx = it * 512 + tid, dkk = idx >> 5, dv4 = (idx & 31) * 4;
                const int col = ((((dkk >> 3) ^ ((dv4 >> 4) & 7)) << 3) | (dkk & 7));
                sT[(dv4 + 0) * 72 + col] = f2bf(sv[hh][it].x); sT[(dv4 + 1) * 72 + col] = f2bf(sv[hh][it].y); sT[(dv4 + 2) * 72 + col] = f2bf(sv[hh][it].z); sT[(dv4 + 3) * 72 + col] = f2bf(sv[hh][it].w);
            }
        }
    }
    LBAR();
#pragma unroll
    for (int hh = 0; hh < 2; ++hh) {
        LAS float* gsum = (LAS float*)(lds + hh * GL_HEAD + GL_GSUM); LAS float* dS = (LAS float*)(lds + hh * GL_HEAD + GL_DS);
        LAS bf16_t* qs = (LAS bf16_t*)(lds + hh * GL_HEAD + GL_QS); LAS bf16_t* ks = (LAS bf16_t*)(lds + hh * GL_HEAD + GL_KS);
        float prefix = 0.f, blast = 0.f;
#pragma unroll
        for (int g2 = 0; g2 < 8; ++g2) { const float v = gsum[g2 * 64 + dk]; blast += v; if (g2 < tg) prefix += v; }
#pragma unroll
        for (int jj = 0; jj < 8; ++jj) {
            const int t = 8 * tg + jj;
            const float bj = prefix + bl[hh][jj];
            const float kv = bf2f(kraw[hh][jj]);
            if (FINAL) { qs[t * 72 + dk] = f2bf(bf2f(qraw[hh][jj]) * 0.125f * __expf(bj)); ks[t * 72 + dk] = f2bf(kv * __expf(-bj)); }
            else ks[dk * 72 + t] = f2bf(kv * __expf(blast - bj));
        }
        if (!FINAL && tg == 0) { const float d = __expf(blast); dS[dk] = d; if (u.prompt) ((float*)(a->ws + WS_DBUF))[(size_t)(unit * 4 + 2 * hp + hh) * 64 + dk] = d; }
    }
    LBAR();
    if (!FINAL) {
#pragma unroll
        for (int hh = 0; hh < 2; ++hh) {
            const int hd = 2 * hp + hh;
            LAS float* dS = (LAS float*)(lds + hh * GL_HEAD + GL_DS);
            LAS bf16_t* ks = (LAS bf16_t*)(lds + hh * GL_HEAD + GL_KS); LAS bf16_t* vT = (LAS bf16_t*)(lds + hh * GL_HEAD + GL_VT);
            const int mb = w >> 2, nb = w & 3;
            f32x16 acc;
#pragma unroll
            for (int i = 0; i < 16; ++i) acc[i] = 0.f;
            mma_blk_swz(acc, ks + mb * 32 * 72, vT, r, h, nb * 32);
            const int dvc = 32 * nb + r;
            if (u.prompt) {
                bf16_t* dst = (bf16_t*)(a->ws + WS_SB) + (size_t)(unit * 4 + hd) * 8192;
#pragma unroll
                for (int i = 0; i < 16; ++i) dst[(32 * mb + crow(i, h)) * 128 + dvc] = f2bf(acc[i]);
            } else {
                float* dst = a->out + O_SS + (size_t)((l * NSB + u.s) * 4 + hd) * 8192;
#pragma unroll
                for (int i = 0; i < 16; ++i) { const int dkr = 32 * mb + crow(i, h); __builtin_nontemporal_store(dS[dkr] * s0v[hh][i] + acc[i], dst + dkr * 128 + dvc); }
            }
        }
    } else {
        {
            const int hh = w >> 2, ww = w & 3, mi = ww >> 1, nj = ww & 1;
            LAS bf16_t* qs = (LAS bf16_t*)(lds + hh * GL_HEAD + GL_QS); LAS bf16_t* ks = (LAS bf16_t*)(lds + hh * GL_HEAD + GL_KS); LAS bf16_t* att = (LAS bf16_t*)(lds + hh * GL_HEAD + GL_ATT);
            f32x16 acc;
#pragma unroll
            for (int i = 0; i < 16; ++i) acc[i] = 0.f;
            if (!(mi == 0 && nj == 1)) mma_blk(acc, qs + mi * 32 * 72, ks + nj * 32 * 72, r, h);
#pragma unroll
            for (int i = 0; i < 16; ++i) { const int irow = 32 * mi + crow(i, h), jcol = 32 * nj + r; att[irow * 72 + jcol] = f2bf(irow >= jcol ? acc[i] : 0.f); }
        }
        LBAR();
        f32x16 oacc[2];
        const int mi = w >> 2, nv = w & 3;
#pragma unroll
        for (int hh = 0; hh < 2; ++hh) {
            LAS bf16_t* qs = (LAS bf16_t*)(lds + hh * GL_HEAD + GL_QS); LAS bf16_t* vT = (LAS bf16_t*)(lds + hh * GL_HEAD + GL_VT);
            LAS bf16_t* sT = (LAS bf16_t*)(lds + hh * GL_HEAD + GL_ST); LAS bf16_t* att = (LAS bf16_t*)(lds + hh * GL_HEAD + GL_ATT);
#pragma unroll
            for (int i = 0; i < 16; ++i) oacc[hh][i] = 0.f;
            mma_blk_swz(oacc[hh], att + mi * 32 * 72, vT, r, h, nv * 32);
            mma_blk_swz(oacc[hh], qs + mi * 32 * 72, sT, r, h, nv * 32);
        }
        LBAR();
#pragma unroll
        for (int hh = 0; hh < 2; ++hh) {
            LAS float* ob = (LAS float*)(lds + hh * GL_HEAD + GL_VT);
#pragma unroll
            for (int i = 0; i < 16; ++i) ob[(32 * mi + crow(i, h)) * 132 + 32 * nv + r] = oacc[hh][i];
        }
        LBAR();
#pragma unroll
        for (int hh = 0; hh < 2; ++hh) {
            const int hd = 2 * hp + hh;
            const LAS float* ob = (const LAS float*)(lds + hh * GL_HEAD + GL_VT);
            const int i = vj, dvc = vdvc;
            float o[16];
#pragma unroll
            for (int q = 0; q < 4; ++q) { const f32x4 v = *(const LAS f32x4*)(ob + i * 132 + dvc + 4 * q); o[4 * q] = v.x; o[4 * q + 1] = v.y; o[4 * q + 2] = v.z; o[4 * q + 3] = v.w; }
            float s = 0.f;
#pragma unroll
            for (int e = 0; e < 16; ++e) s += o[e] * o[e];
            s += __shfl_xor(s, 1); s += __shfl_xor(s, 2); s += __shfl_xor(s, 4);
            const float rs = rsqrtf(s * (1.f / DV) + EPS);
            if (i < nvalid) {
                float go[16]; unpack8(g0[hh], go); unpack8(g1[hh], go + 8);
                float y[16];
#pragma unroll
                for (int e = 0; e < 16; ++e) y[e] = o[e] * rs * gnv[e >> 2][e & 3] * siluf_(go[e]);
                u32x4 w0, w1;
                w0.x = cvt_pk(y[0], y[1]); w0.y = cvt_pk(y[2], y[3]); w0.z = cvt_pk(y[4], y[5]); w0.w = cvt_pk(y[6], y[7]);
                w1.x = cvt_pk(y[8], y[9]); w1.y = cvt_pk(y[10], y[11]); w1.z = cvt_pk(y[12], y[13]); w1.w = cvt_pk(y[14], y[15]);
                u32x4* yp = (u32x4*)((bf16_t*)(a->ws + WS_Y) + (size_t)(row0 + i) * DM + DLRU + hd * 128 + dvc);
                yp[0] = w0; yp[1] = w1;
            }
        }
    }
    LBAR();
}

DI void state_scan(KA a, int l) {
    const int gt = blockIdx.x * 512 + opaque_tid(), NGT = gridDim.x * 512;
    float* SB = (float*)(a->ws + WS_SB); const float* db = (const float*)(a->ws + WS_DBUF);
    bf16_t* SBh = (bf16_t*)SB;
    for (int q = gt; q < NB * NH * 1024; q += NGT) {
        const int e = (q & 1023) * 8, bh = q >> 10, b = bh >> 2, hd = bh & 3, dkk = e >> 7;
        float S[8];
#pragma unroll
        for (int k = 0; k < 8; ++k) S[k] = 0.f;
#pragma unroll 11
        for (int c = 0; c < NCH; ++c) {
            const int uu = b * NCH + c;
            u32x4* p = (u32x4*)(SBh + (size_t)(uu * 4 + hd) * 8192 + e);
            float uv[8]; unpack8(*p, uv);
            const float d = db[(size_t)(uu * 4 + hd) * 64 + dkk];
            u32x4 w; w.x = cvt_pk(S[0], S[1]); w.y = cvt_pk(S[2], S[3]); w.z = cvt_pk(S[4], S[5]); w.w = cvt_pk(S[6], S[7]);
            *p = w;
#pragma unroll
            for (int k = 0; k < 8; ++k) S[k] = d * S[k] + uv[k];
        }
        float* o = a->out + O_SP + (size_t)((l * NB + b) * 4 + hd) * 8192 + e;
        *(f32x4*)o = (f32x4){S[0], S[1], S[2], S[3]}; *(f32x4*)(o + 4) = (f32x4){S[4], S[5], S[6], S[7]};
    }
    { u32x4* p = (u32x4*)((bf16_t*)(a->ws + WS_Y) + (size_t)MTOK * DM); const int n = (MPAD - MTOK) * DM / 8; for (int i = gt; i < n; i += NGT) p[i] = (u32x4){0u, 0u, 0u, 0u}; }
}

#define XB_TMO      128
#define XB_XCNT(j)  (256  + 64 * (j))
#define XB_XSUB(j)  (1280 + 64 * (j))
#define XB_XGEN(j)  (2304 + 64 * (j))
#define XB_TOP      3328
#define XB_TOPGEN   3392
#define XCD_BAR_WORDS 3456
#define XB_SPIN_CAP (1u << 20)
DI unsigned xb_ld(unsigned* p)              { return __hip_atomic_load(p, __ATOMIC_RELAXED, __HIP_MEMORY_SCOPE_AGENT); }
DI unsigned xb_add(unsigned* p, unsigned v) { return __hip_atomic_fetch_add(p, v, __ATOMIC_RELAXED, __HIP_MEMORY_SCOPE_AGENT); }
DI unsigned xb_xcc_id() { return (unsigned)__builtin_amdgcn_s_getreg((3 << 11) | 20) & 0xFu; }
#define XB_SPIN(cond, bar) do { unsigned _sp = 0; while (cond) { \
    if ((++_sp & 255u) == 0u) { if (xb_ld(&(bar)[XB_TMO])) break; if (_sp > XB_SPIN_CAP) { atomicAdd(&(bar)[XB_TMO], 1u); break; } } } } while (0)
struct XcdBarrier { unsigned* bar; unsigned x; volatile LAS unsigned* st; };
DI XcdBarrier xcd_barrier_post(unsigned* bar, volatile LAS unsigned* st) {
    XcdBarrier b; b.bar = bar; b.x = xb_xcc_id(); b.st = st;
    if (threadIdx.x == 0) (void)xb_add(&bar[XB_XCNT(b.x)], 1u);
    return b;
}
DI void xcd_barrier_complete(unsigned* bar, unsigned x, unsigned& nloc, unsigned& nx) {
    const unsigned G = gridDim.x * gridDim.y * gridDim.z;
    unsigned sum, cnt, mine, sp = 0u;
    for (;;) {
        sum = 0u; cnt = 0u; mine = 0u;
#pragma unroll
        for (unsigned j = 0; j < 16; ++j) { const unsigned c = xb_ld(&bar[XB_XCNT(j)]); sum += c; cnt += (c > 0u) ? 1u : 0u; mine = (j == x) ? c : mine; }
        if (sum == G) break;
        __builtin_amdgcn_s_sleep(1);
        if ((++sp & 255u) == 0u) { if (xb_ld(&bar[XB_TMO])) break; if (sp > XB_SPIN_CAP) { atomicAdd(&bar[XB_TMO], 1u); break; } }
    }
    nloc = mine > 0u ? mine : 1u; nx = cnt > 0u ? cnt : 1u;
}
DI void xcd_barrier(const XcdBarrier& b) {
    asm volatile("s_waitcnt vmcnt(0)" ::: "memory");
    __syncthreads();
    if (threadIdx.x == 0) {
        unsigned* bar = b.bar;
        __builtin_amdgcn_s_waitcnt(0);
        unsigned nloc = b.st[0], nx = b.st[1];
        if (nloc == 0u) { xcd_barrier_complete(bar, b.x, nloc, nx); b.st[0] = nloc; b.st[1] = nx; }
        const unsigned old = xb_add(&bar[XB_XSUB(b.x)], 1u);
        const unsigned gen = old / nloc;
        if (old + 1u == (gen + 1u) * nloc) {
            __builtin_amdgcn_fence(__ATOMIC_RELEASE, "agent");
            asm volatile("s_waitcnt vmcnt(0)" ::: "memory");
            const unsigned og = xb_add(&bar[XB_TOP], 1u);
            const unsigned tg = og / nx;
            if (og + 1u == (tg + 1u) * nx) xb_add(&bar[XB_TOPGEN], 1u);
            else XB_SPIN(xb_ld(&bar[XB_TOPGEN]) == tg, bar);
            __builtin_amdgcn_fence(__ATOMIC_ACQUIRE, "agent");
            xb_add(&bar[XB_XGEN(b.x)], 1u);
            asm volatile("s_waitcnt vmcnt(0)" ::: "memory");
        } else {
            XB_SPIN(xb_ld(&bar[XB_XGEN(b.x)]) == gen, bar);
            __builtin_amdgcn_fence(__ATOMIC_ACQUIRE, "agent");
            asm volatile("s_waitcnt vmcnt(0)" ::: "memory");
        }
    }
    __syncthreads();
}

#ifndef REP_M1
#define REP_M1 1
#endif
#ifndef REP_M3L
#define REP_M3L 1
#endif
#ifndef REP_M3G
#define REP_M3G 1
#endif
#ifndef REP_SYNC
#define REP_SYNC 1
#endif
#ifndef REP_G
#define REP_G 1
#endif
template <class Epi, class... EA>
DI void run_gemm(LAS unsigned char* lds, size_t offA, size_t offB, int N, int K, const EA&... ea) {
    const KA a = get_ka(); unsigned char* ws = a->ws;
    pg8::Gemm g{(const bf16_t*)(ws + offA), (const bf16_t*)(ws + offB), MPAD, N, K}; pg8::StaticOrder S; S.init(MPAD, N, K, gridDim.x, blockIdx.x);
    const Epi E = Epi::make(ws, ea...);
    pg8::gemm_phase<Epi, pg8::StaticOrder, true, true>(lds, g, S, E);
}
DI void run_gemm_res(LAS unsigned char* lds, size_t offA, size_t offB, int K, int ssi, float sc, size_t part_off, unsigned epoch) {
    const KA a = get_ka(); unsigned char* ws = a->ws;
    pg8::Gemm g{(const bf16_t*)(ws + offA), (const bf16_t*)(ws + offB), MPAD, DM, K};
    const pg8::EpiRes E = pg8::EpiRes::make(ws, ssi, sc, part_off, epoch);
    const int G = gridDim.x, bx = blockIdx.x;
    if ((G & 7) == 0 && (long)276 * (K / 128) >= (long)G * (K / 128)) {
        pg8::SKOrder S; S.init(K, G, (bx & 7) * (G >> 3) + (bx >> 3));
        pg8::gemm_phase<pg8::EpiRes, pg8::SKOrder, true, true>(lds, g, S, E);
    } else {
        pg8::StaticOrder S; S.init(MPAD, DM, K, G, bx);
        pg8::gemm_phase<pg8::EpiRes, pg8::StaticOrder, true, true>(lds, g, S, E);
    }
}

__global__ void __launch_bounds__(512, 2) hymba_fwd(Args a_unused) {
    extern __shared__ __attribute__((aligned(16))) unsigned char lds_raw[];
    LAS unsigned char* lds = (LAS unsigned char*)lds_raw;
    cg::grid_group grid = cg::this_grid();
    if (gridDim.x == 0x7fffffffu) grid.sync();
    volatile LAS unsigned* bst = (volatile LAS unsigned*)(lds + 147200);
    if (threadIdx.x < 2) bst[threadIdx.x] = 0u;
    __syncthreads();
    (void)xcd_barrier_post((unsigned*)(get_ka()->ws), bst);
#define GSYNC() do { XcdBarrier _b; _b.bar = (unsigned*)(get_ka()->ws); _b.x = xb_xcc_id(); _b.st = (volatile LAS unsigned*)(lds + 147200); xcd_barrier(_b); } while (0)

#ifndef REP_PRO
#define REP_PRO 1
#endif
    for (int rep = 0; rep < REP_PRO; ++rep) { prologue(get_ka(), lds); __syncthreads(); }
    GSYNC();
#pragma unroll 1
    for (int l = 0; l < 2; ++l) {
        if (l == 1) {
            const int tid = opaque_tid(), wave = tid >> 6, lane = tid & 63;
            for (int rep = 0; rep < REP_PRO; ++rep) { convert_layer_weights(get_ka(), 1, lds, blockIdx.x * 8 + wave, gridDim.x * 8, wave, lane); __syncthreads(); }
            GSYNC();
        }
        for (int rep = 0; rep < REP_G; ++rep)
        run_gemm<pg8::EpiSwiGLU>(lds, WS_XB, WS_WGU1, 2 * DFF, DM, 3 * l + 0);
        for (int rep = 0; rep < REP_SYNC; ++rep)
        GSYNC();
        run_gemm_res(lds, WS_HU, WS_WD1, DFF, 3 * l + 1, 0.5f, WS_Y, 3 * l + 1);
        GSYNC();
        run_gemm<pg8::EpiRowScale>(lds, WS_XB, WS_WIN, UN, DM, 3 * l + 1);
        GSYNC();
        for (int rep = 0; rep < REP_M1; ++rep)
        for (int it = blockIdx.x; it < 2 * NUNIT; it += gridDim.x) gla_unit<false>(get_ka(), l, it, lds);
        GSYNC();
        state_scan(get_ka(), l);
        GSYNC();
        for (int it = blockIdx.x; it < NUNIT + 2 * NUNIT; it += gridDim.x) {
            if (it < NUNIT) { lru_unit<true>(get_ka(), l, it, lds); LBAR(); }
            else { for (int rep = 0; rep < REP_M3G; ++rep) gla_unit<true>(get_ka(), l, it - NUNIT, lds); }
        }
        GSYNC();
        run_gemm_res(lds, WS_Y, WS_WOUT, DM, 3 * l + 2, 1.0f, WS_HU, 3 * l + 2);
        GSYNC();
        run_gemm<pg8::EpiSwiGLU>(lds, WS_XB, WS_WGU2, 2 * DFF, DM, 3 * l + 2);
        GSYNC();
        run_gemm_res(lds, WS_HU, WS_WD2, DFF, 3 * l + 3, 0.5f, WS_Y, 3 * l + 3);
        GSYNC();
    }
    {
        const KA a = get_ka();
        const int tid = opaque_tid(), wave = tid >> 6, lane = tid & 63, G = gridDim.x;
        const float* nf = a->in[25];
        const float* ssf = (const float*)(a->ws + WS_SS) + 6 * MPAD;
        const bf16_t* XB = (const bf16_t*)(a->ws + WS_XB);
        float* out = a->out;
        for (int rowb = blockIdx.x * 8 + wave; rowb < MTOK; rowb += 2 * G * 8) {
            float* dst[2]; u32x4 xr[2][2]; float rs[2];
#pragma unroll
            for (int q = 0; q < 2; ++q) {
                const int row = rowb + q * G * 8;
                dst[q] = nullptr;
                if (row < MP) { const int b = row / LP, t = row - b * LP; if (t >= NMETA) dst[q] = out + O_YP + ((size_t)b * SEQ + (t - NMETA)) * DM; }
                else if (row < MTOK) dst[q] = out + O_YS + (size_t)(row - MP) * DM;
                if (dst[q]) { rs[q] = rsqrtf(ssf[row] * (1.f / DM) + EPS); const u32x4* src = (const u32x4*)(XB + (size_t)row * DM); xr[q][0] = src[lane]; xr[q][1] = src[lane + 64]; }
            }
#pragma unroll
            for (int q = 0; q < 2; ++q) {
                if (dst[q]) {
#pragma unroll
                    for (int j = 0; j < 2; ++j) {
                        const int c8 = (lane + 64 * j) * 8;
                        float xv[8]; unpack8(xr[q][j], xv);
                        const f32x4 n0 = *(const f32x4*)(nf + c8), n1 = *(const f32x4*)(nf + c8 + 4);
                        const float r = rs[q];
                        __builtin_nontemporal_store((f32x4){xv[0] * r * n0.x, xv[1] * r * n0.y, xv[2] * r * n0.z, xv[3] * r * n0.w}, (f32x4*)(dst[q] + c8));
                        __builtin_nontemporal_store((f32x4){xv[4] * r * n1.x, xv[5] * r * n1.y, xv[6] * r * n1.z, xv[7] * r * n1.w}, (f32x4*)(dst[q] + c8 + 4));
                    }
                }
            }
        }
    }
}

extern "C" void kernel_launch(void* const* d_in, const int* in_sizes, int n_in, void* d_out, int out_size, void* d_ws, size_t ws_size, hipStream_t stream) {
    static int grid = 0;
    if (grid == 0) {
        if (n_in != 26 || ws_size < WS_END) { fprintf(stderr, "kernel_launch: unexpected n_in %d / ws_size %zu\n", n_in, ws_size); grid = -1; return; }
        int dev = 0, cus = 0, per_cu = 0;
        hipGetDevice(&dev);
        hipDeviceGetAttribute(&cus, hipDeviceAttributeMultiprocessorCount, dev);
        if (hipFuncSetAttribute((const void*)hymba_fwd, hipFuncAttributeMaxDynamicSharedMemorySize, LDS_BYTES) != hipSuccess) { fprintf(stderr, "kernel_launch: hipFuncSetAttribute failed\n"); grid = -1; return; }
        if (hipOccupancyMaxActiveBlocksPerMultiprocessor(&per_cu, (const void*)hymba_fwd, 512, LDS_BYTES) != hipSuccess || per_cu < 1) { fprintf(stderr, "kernel_launch: occupancy query says %d\n", per_cu); per_cu = 1; }
        (void)hipGetLastError();
        grid = cus;
    }
    if (grid < 0) return;
    if (hipMemsetAsync(d_ws, 0, 65536, stream) != hipSuccess) { fprintf(stderr, "kernel_launch: memset failed\n"); return; }
    Args a{};
    for (int i = 0; i < 26; ++i) a.in[i] = (const float*)d_in[i];
    a.out = (float*)d_out; a.ws = (unsigned char*)d_ws;
    void* args[] = {&a};
    hipError_t e = hipLaunchCooperativeKernel((const void*)hymba_fwd, dim3(grid), dim3(512), args, LDS_BYTES, stream);
    if (e != hipSuccess) fprintf(stderr, "cooperative launch failed: %s (grid %d)\n", hipGetErrorString(e), grid);
}
```
